# Optimizing an MI355X kernel written in HIP

```python
import math
import jax
import jax.numpy as jnp
from jax import lax
import numpy as np

D_MODEL = 1024
BATCH = 4
SEQ = 4096
DEPTH = 4

N_HEADS = 16
HEAD_DIM = 64
A_HEADS = 8
B_HEADS = 8
MOBA_BLOCK = 256
MOBA_TOPK = 3
MOBA_Q_CHUNK = 64
IDX_HEADS = 16
IDX_DIM = 64
DSA_TOPK_MAX = 256
DSA_Q_CHUNK = 128
DILATED_PATTERNS = ((128, 1), (512, 4), (2048, 16))
REL_BUCKETS = 32
REL_MAX_DIST = 128
D_FF = 2816
CONV_WIDTH = 3
RMS_EPS = 1e-6

kernel_name = 'hybrid_moba_dsa_dilated_convffn'


def rmsnorm(x, g):
    x32 = x.astype(jnp.float32)
    y = x32 * lax.rsqrt(jnp.mean(x32 * x32, axis=-1, keepdims=True) + RMS_EPS)
    return (y * g.astype(jnp.float32)).astype(x.dtype)


def t5_bucket(dist):
    n = jnp.maximum(dist, 0)
    max_exact = REL_BUCKETS // 2
    nf = jnp.maximum(n, max_exact).astype(jnp.float32)
    large = max_exact + (jnp.log(nf / max_exact) / math.log(REL_MAX_DIST / max_exact)
                         * (REL_BUCKETS - max_exact)).astype(jnp.int32)
    large = jnp.minimum(large, REL_BUCKETS - 1)
    return jnp.where(n < max_exact, n, large)


def split_cols(a, sizes):
    out, off = [], 0
    for s in sizes:
        out.append(a[..., off:off + s])
        off += s
    return out


def moba_attention(q, k, v, table_hk):
    B, H, S, Dh = q.shape
    nb = -(-S // MOBA_BLOCK)
    pad = nb * MOBA_BLOCK - S
    kb = jnp.pad(k, ((0, 0), (0, 0), (0, pad), (0, 0))).reshape(B, H, nb, MOBA_BLOCK, Dh)
    vb = jnp.pad(v, ((0, 0), (0, 0), (0, pad), (0, 0))).reshape(B, H, nb, MOBA_BLOCK, Dh)
    kmean = jnp.mean(kb.astype(jnp.float32), axis=3).astype(k.dtype)
    n_sel = min(MOBA_TOPK, nb - 1)
    scale = Dh ** -0.5
    nq = S // MOBA_Q_CHUNK
    qc = jnp.moveaxis(q.reshape(B, H, nq, MOBA_Q_CHUNK, Dh), 2, 0)
    bi = jnp.arange(B)[:, None, None, None]
    hi = jnp.arange(H)[None, :, None, None]
    offs = jnp.arange(MOBA_BLOCK)
    blk_ids = jnp.arange(nb)

    def chunk(args):
        qi, c = args
        q0 = c * MOBA_Q_CHUNK
        t = q0 + jnp.arange(MOBA_Q_CHUNK)
        own = q0 // MOBA_BLOCK
        k_own = lax.dynamic_index_in_dim(kb, own, axis=2, keepdims=False)
        v_own = lax.dynamic_index_in_dim(vb, own, axis=2, keepdims=False)
        d_own = t[:, None] - (own * MOBA_BLOCK + offs)[None, :]
        l_own = jnp.einsum('bhqd,bhkd->bhqk', qi, k_own).astype(jnp.float32) * scale
        l_own = jnp.where(d_own >= 0, l_own + table_hk[:, t5_bucket(d_own)], -jnp.inf)
        if n_sel == 0:
            p = jax.nn.softmax(l_own, axis=-1).astype(v.dtype)
            return jnp.einsum('bhqk,bhkd->bhqd', p, v_own)
        gate = jnp.einsum('bhqd,bhnd->bhqn', qi, kmean).astype(jnp.float32)
        gate = jnp.where(blk_ids < own, gate, -jnp.inf)
        _, sel = lax.top_k(gate, n_sel)
        k_sel = kb[bi, hi, sel]
        v_sel = vb[bi, hi, sel]
        d_sel = t[None, None, :, None, None] - (sel[..., None] * MOBA_BLOCK + offs)
        l_sel = jnp.einsum('bhqd,bhqnkd->bhqnk', qi, k_sel).astype(jnp.float32) * scale
        l_sel = l_sel + table_hk[hi[..., None], t5_bucket(d_sel)]
        l_sel = jnp.where((sel < own)[..., None], l_sel, -jnp.inf)
        n_k = n_sel * MOBA_BLOCK
        logits = jnp.concatenate([l_sel.reshape(B, H, MOBA_Q_CHUNK, n_k), l_own], axis=-1)
        p = jax.nn.softmax(logits, axis=-1).astype(v.dtype)
        p_sel = p[..., :n_k].reshape(B, H, MOBA_Q_CHUNK, n_sel, MOBA_BLOCK)
        p_own = p[..., n_k:]
        return (jnp.einsum('bhqnk,bhqnkd->bhqd', p_sel, v_sel)
                + jnp.einsum('bhqk,bhkd->bhqd', p_own, v_own))

    out = lax.map(chunk, (qc, jnp.arange(nq, dtype=jnp.int32)))
    return jnp.moveaxis(out, 0, 2).reshape(B, H, S, Dh)


def dsa_attention(q, k, v, q_idx, k_idx, w_idx, table_hk):
    B, S, H, Dh = q.shape
    n_keep = min(DSA_TOPK_MAX, S // 4)
    nq = S // DSA_Q_CHUNK
    scale = Dh ** -0.5
    key_pos = jnp.arange(S)
    bi = jnp.arange(B)[:, None, None]

    def chunkify(a):
        return jnp.moveaxis(a.reshape((B, nq, DSA_Q_CHUNK) + a.shape[2:]), 1, 0)

    def chunk(args):
        qi, qii, wi, c = args
        t = c * DSA_Q_CHUNK + jnp.arange(DSA_Q_CHUNK)
        rel = jax.nn.relu(jnp.einsum('bqhd,bsd->bqhs', qii, k_idx) * (IDX_DIM ** -0.5))
        score = jnp.einsum('bqhs,bqh->bqs', rel, wi).astype(jnp.float32)
        score = jnp.where(key_pos[None, :] <= t[:, None], score, -jnp.inf)
        _, sel = lax.top_k(score, n_keep)
        k_sel = k[bi, sel]
        v_sel = v[bi, sel]
        d = t[None, :, None] - sel
        logits = jnp.einsum('bqhd,bqkhd->bhqk', qi, k_sel).astype(jnp.float32) * scale
        logits = logits + jnp.moveaxis(table_hk[:, t5_bucket(d)], 0, 1)
        logits = jnp.where((d >= 0)[:, None], logits, -jnp.inf)
        p = jax.nn.softmax(logits, axis=-1).astype(v.dtype)
        return jnp.einsum('bhqk,bqkhd->bqhd', p, v_sel)

    out = lax.map(chunk, (chunkify(q), chunkify(q_idx), chunkify(w_idx),
                          jnp.arange(nq, dtype=jnp.int32)))
    return jnp.moveaxis(out, 0, 1).reshape(B, S, H, Dh)


def dilated_branch(q, k, v, table_hk, window, dilation):
    B, H, S, Dh = q.shape
    w_sub = window // dilation
    bb = w_sub
    n = S // dilation
    nbk = -(-n // bb)
    npad = nbk * bb
    scale = Dh ** -0.5

    def to_sub(a):
        a = jnp.swapaxes(a.reshape(B, H, n, dilation, Dh), 2, 3)
        return jnp.pad(a, ((0, 0), (0, 0), (0, 0), (0, npad - n), (0, 0)))

    def band(a):
        ap = jnp.pad(a, ((0, 0), (0, 0), (0, 0), (bb, 0), (0, 0)))
        prev = ap[:, :, :, :npad].reshape(B, H, dilation, nbk, bb, Dh)
        cur = a.reshape(B, H, dilation, nbk, bb, Dh)
        return jnp.concatenate([prev, cur], axis=4)

    qs = to_sub(q).reshape(B, H, dilation, nbk, bb, Dh)
    kband = band(to_sub(k))
    vband = band(to_sub(v))
    logits = jnp.einsum('bhrnqd,bhrnkd->bhrnqk', qs, kband).astype(jnp.float32) * scale
    a_i = jnp.arange(bb)
    m_i = jnp.arange(2 * bb)
    di = a_i[:, None] + bb - m_i[None, :]
    band_ok = (di >= 0) & (di <= w_sub)
    j_idx = jnp.arange(nbk)[:, None] * bb - bb + m_i[None, :]
    mask = band_ok[None] & (j_idx >= 0)[:, None, :]
    bias = table_hk[:, t5_bucket(di * dilation)][:, None, None]
    logits = jnp.where(mask, logits + bias, -jnp.inf)
    mx = jnp.max(logits, axis=-1, keepdims=True)
    e = jnp.exp(logits - mx)
    den = jnp.sum(e, axis=-1, keepdims=True)
    o = jnp.einsum('bhrnqk,bhrnkd->bhrnqd', (e / den).astype(v.dtype), vband)
    lse = (mx + jnp.log(den))[..., 0]
    o = jnp.swapaxes(o.reshape(B, H, dilation, npad, Dh)[:, :, :, :n], 2, 3).reshape(B, H, S, Dh)
    lse = jnp.swapaxes(lse.reshape(B, H, dilation, npad)[:, :, :, :n], 2, 3).reshape(B, H, S)
    return o, lse


def dilated_mixture(q, k, v, table_hk):
    outs, lses = [], []
    for window, dilation in DILATED_PATTERNS:
        o, l = dilated_branch(q, k, v, table_hk, window, dilation)
        outs.append(o)
        lses.append(l)
    alpha = jax.nn.softmax(jnp.stack(lses, axis=0), axis=0)
    return jnp.einsum('pbhs,pbhsd->bhsd', alpha.astype(v.dtype), jnp.stack(outs, axis=0))


def conv_ffn(h, w_up, conv_w, conv_b, w_down):
    S = h.shape[1]
    u = h @ w_up
    up = jnp.pad(u, ((0, 0), (CONV_WIDTH - 1, 0), (0, 0)))
    c = conv_b
    for j in range(CONV_WIDTH):
        c = c + conv_w[j] * up[:, j:j + S]
    val, gate = jnp.split(c, 2, axis=-1)
    return (jax.nn.silu(gate) * val) @ w_down


def setup_inputs(seed: int = 0) -> dict:
    key = jax.random.key(seed)
    ks = jax.random.split(key, 13)
    n_even = (DEPTH + 1) // 2
    n_odd = DEPTH // 2
    even_in = 3 * A_HEADS * HEAD_DIM + 3 * B_HEADS * HEAD_DIM + IDX_HEADS * IDX_DIM + IDX_DIM + IDX_HEADS
    odd_in = 3 * N_HEADS * HEAD_DIM
    mix = N_HEADS * HEAD_DIM

    def nrm(k, shape, s):
        return jax.random.normal(k, shape, jnp.float32) * s

    return {
        'x': nrm(ks[0], (BATCH, SEQ, D_MODEL), 1.0),
        'w_in_even': nrm(ks[1], (n_even, D_MODEL, even_in), D_MODEL ** -0.5),
        'idx_k_norm': 1.0 + nrm(ks[2], (n_even, IDX_DIM), 0.02),
        'w_in_odd': nrm(ks[3], (n_odd, D_MODEL, odd_in), D_MODEL ** -0.5),
        'w_o': nrm(ks[4], (DEPTH, mix, D_MODEL), mix ** -0.5),
        'rel_bias': nrm(ks[5], (REL_BUCKETS, N_HEADS), 0.2),
        'attn_norm': 1.0 + nrm(ks[6], (DEPTH, D_MODEL), 0.02),
        'ffn_norm': 1.0 + nrm(ks[7], (DEPTH, D_MODEL), 0.02),
        'w_up': nrm(ks[8], (DEPTH, D_MODEL, 2 * D_FF), D_MODEL ** -0.5),
        'conv_w': nrm(ks[9], (DEPTH, CONV_WIDTH, 2 * D_FF), CONV_WIDTH ** -0.5),
        'conv_b': nrm(ks[10], (DEPTH, 2 * D_FF), 0.02),
        'w_down': nrm(ks[11], (DEPTH, D_FF, D_MODEL), D_FF ** -0.5),
        'final_norm': 1.0 + nrm(ks[12], (D_MODEL,), 0.02),
    }


def reference(x, w_in_even, idx_k_norm, w_in_odd, w_o, rel_bias, attn_norm, ffn_norm,
              w_up, conv_w, conv_b, w_down, final_norm):
    B, S, _ = x.shape
    mix = N_HEADS * HEAD_DIM
    sizes_even = [A_HEADS * HEAD_DIM] * 3 + [B_HEADS * HEAD_DIM] * 3 + [IDX_HEADS * IDX_DIM, IDX_DIM, IDX_HEADS]
    sizes_odd = [N_HEADS * HEAD_DIM] * 3
    table_a = rel_bias[:, :A_HEADS].T
    table_b = rel_bias[:, A_HEADS:A_HEADS + B_HEADS].T
    table_c = rel_bias.T
    for layer in range(DEPTH):
        h = rmsnorm(x, attn_norm[layer])
        if layer % 2 == 0:
            j = layer // 2
            qa, ka, va, qb, kb, vb, qi, ki, wi = split_cols(h @ w_in_even[j], sizes_even)
            qa, ka, va = (jnp.swapaxes(a.reshape(B, S, A_HEADS, HEAD_DIM), 1, 2) for a in (qa, ka, va))
            o_a = jnp.swapaxes(moba_attention(qa, ka, va, table_a), 1, 2)
            qb, kb, vb = (a.reshape(B, S, B_HEADS, HEAD_DIM) for a in (qb, kb, vb))
            o_b = dsa_attention(qb, kb, vb,
                                qi.reshape(B, S, IDX_HEADS, IDX_DIM),
                                rmsnorm(ki, idx_k_norm[j]),
                                wi * (IDX_HEADS ** -0.5),
                                table_b)
            mixed = jnp.concatenate([o_a, o_b], axis=2).reshape(B, S, mix)
        else:
            j = layer // 2
            qc, kc, vc = (jnp.swapaxes(a.reshape(B, S, N_HEADS, HEAD_DIM), 1, 2)
                          for a in split_cols(h @ w_in_odd[j], sizes_odd))
            o_c = dilated_mixture(qc, kc, vc, table_c)
            mixed = jnp.swapaxes(o_c, 1, 2).reshape(B, S, mix)
        x = x + mixed @ w_o[layer]
        h = rmsnorm(x, ffn_norm[layer])
        x = x + conv_ffn(h, w_up[layer], conv_w[layer], conv_b[layer], w_down[layer])
    return rmsnorm(x, final_norm)
```

```cpp
#include <hip/hip_runtime.h>
#include <hip/hip_bf16.h>
#include <cstdio>
#include <cstdint>
#include <cmath>

constexpr int BATCH = 4, SEQ = 4096, M = BATCH * SEQ, D = 1024, NH = 16, HD = 64, FF = 2816, NUP = 2 * FF, DEPTH = 4;
constexpr int EVEN_IN = 4176, NIN_E = 4352  , NIN_O = 3072;
constexpr float RMS_EPS = 1e-6f;
constexpr float LOG2E = 1.4426950408889634f;
constexpr float C2 = 0.125f * LOG2E;
namespace pg8 {
#define PG8_LAS __attribute__((address_space(3)))
typedef unsigned short bf16_t;
typedef short bf16x8 __attribute__((ext_vector_type(8)));
typedef float f32x4 __attribute__((ext_vector_type(4)));
typedef unsigned u32x4 __attribute__((ext_vector_type(4)));
constexpr int BM = 256, BK = 64, HALF = 128, HTB = HALF * BK * 2  , STAGE_BYTES = 8 * HTB, NXCD = 8, WGM = 8;

__host__ __device__ __forceinline__ int lds_byte(int r, int c) { const int st = (r >> 4) * 2 + (c >> 5), rr = r & 15, cc = c & 31, ob = rr * 64 + cc * 2; return st * 1024 + (ob ^ (((ob >> 9) & 1) << 5)); }
__host__ __device__ __forceinline__ void stage_rc(int b, int& R, int& C) { const int st = b / 1024, sb = b % 1024, swz = sb ^ (((sb >> 9) & 1) << 5); R = (st >> 1) * 16 + swz / 64; C = (st & 1) * 32 + (swz % 64) / 2; }
__host__ __device__ __forceinline__ int perm32(int rho) { const int n = rho >> 4, i = rho & 15; return 8 * (i >> 2) + 4 * n + (i & 3); }

struct Unit { int pm, pn; };
struct Gemm { const bf16_t* A; const bf16_t* Bt; int M, N, K; };

struct StaticOrder {
    int nM, nN, nwg, G, c;
    __host__ __device__ void init(int M, int N, int G_, int c_) { nM = M / BM; nN = N / BM; nwg = nM * nN; G = G_; c = c_; }
    __host__ __device__ bool next(int i, Unit& u) const {
        const long L = (long)i * G + c; if (L >= nwg) return false;
        int wgid = (int)L; { const int q = nwg / NXCD, r = nwg % NXCD, xcd = wgid % NXCD, off = wgid / NXCD; wgid = (xcd < r ? xcd * (q + 1) : r * (q + 1) + (xcd - r) * q) + off; }
        const int nig = WGM * nN, gid = wgid / nig, fm = gid * WGM, gsz = (nM - fm) < WGM ? (nM - fm) : WGM;
        u.pm = fm + ((wgid % nig) % gsz); u.pn = (wgid % nig) / gsz; return true;
    }
    __device__ __forceinline__ void a_ready(const Unit&) const {}
    __device__ __forceinline__ void done(const Unit&) const {}
};

__device__ __forceinline__ unsigned cvt_pk_bf16(float lo, float hi) { unsigned r; asm volatile("v_cvt_pk_bf16_f32 %0, %1, %2" : "=v"(r) : "v"(lo), "v"(hi)); return r; }
typedef float f32x2 __attribute__((ext_vector_type(2)));
template <int CTRL> __device__ __forceinline__ float dpp_mov(float old, float src) {
    return __builtin_bit_cast(float, __builtin_amdgcn_update_dpp(__builtin_bit_cast(int, old), __builtin_bit_cast(int, src), CTRL, 0xF, 0xF, false));
}
__device__ __forceinline__ float shift1(float x, float y) { return dpp_mov<0x111>(dpp_mov<0x121>(0.f, y), x); }
__device__ __forceinline__ float shift2(float x, float y) { return dpp_mov<0x112>(dpp_mov<0x122>(0.f, y), x); }
__device__ __forceinline__ float dot4(const f32x4 a) { return (a[0] * a[0] + a[1] * a[1]) + (a[2] * a[2] + a[3] * a[3]); }
__device__ __forceinline__ float row_rstd(const float* SSP, int row) {
    const f32x4 a = *(const f32x4*)(SSP + (size_t)row * 4);
    return __builtin_amdgcn_rsqf(((a[0] + a[1]) + (a[2] + a[3])) * (1.0f / 1024.0f) + 1e-6f);
}

struct EpiIn {
    static constexpr bool PERM = true, AFTER_DRAIN = false;
    bf16_t *Q, *K, *V, *QI, *KIB; float *WI, *KISS, *KM; const float* SS; int even;
    __device__ __forceinline__ void operator()(const f32x4 (&acc)[2][2][4][2], const Unit& u, int wr, int wc, int fr_, int fq_) const {
        int fr = fr_, fq = fq_; asm volatile("" : "+v"(fr), "+v"(fq));
        const int row0 = u.pm * BM + wr * 64 + fr;
        float rs[2][4];
#pragma unroll
        for (int ai = 0; ai < 2; ++ai)
#pragma unroll
            for (int m = 0; m < 4; ++m) rs[ai][m] = row_rstd(SS, row0 + ai * HALF + m * 16);
        if (u.pn < 16) {
            const int t = u.pn >> 2, colt = (u.pn & 3) * BM;
            bf16_t* base = t == 0 ? Q : (t == 1 ? K : (t == 2 ? V : QI));
            const float sc = t == 0 ? C2 : 1.f;
            const int col0 = colt + wc * 32 + 8 * fq;
#pragma unroll
            for (int ai = 0; ai < 2; ++ai)
#pragma unroll
                for (int m = 0; m < 4; ++m) { const float s = rs[ai][m] * sc; bf16_t* rowp = base + (size_t)(row0 + ai * HALF + m * 16) * 1024 + col0;
#pragma unroll
                    for (int bj = 0; bj < 2; ++bj) { const f32x4 v0 = acc[ai][bj][m][0] * s, v1 = acc[ai][bj][m][1] * s;
                        u32x4 w; w.x = cvt_pk_bf16(v0[0], v0[1]); w.y = cvt_pk_bf16(v0[2], v0[3]); w.z = cvt_pk_bf16(v1[0], v1[1]); w.w = cvt_pk_bf16(v1[2], v1[3]);
                        *(u32x4*)(rowp + bj * HALF) = w; } }
            if (even && t == 1 && (u.pn & 3) < 2) {
#pragma unroll
                for (int bj = 0; bj < 2; ++bj)
#pragma unroll
                    for (int n = 0; n < 2; ++n) { f32x4 s = {0.f, 0.f, 0.f, 0.f};
#pragma unroll
                        for (int ai = 0; ai < 2; ++ai)
#pragma unroll
                            for (int m = 0; m < 4; ++m) s += acc[ai][bj][m][n] * rs[ai][m];
#pragma unroll
                        for (int o = 1; o < 16; o <<= 1) { s[0] += __shfl_xor(s[0], o); s[1] += __shfl_xor(s[1], o); s[2] += __shfl_xor(s[2], o); s[3] += __shfl_xor(s[3], o); }
                        if (fr == 0) { const int col = colt + bj * HALF + wc * 32 + 8 * fq + 4 * n, h = col >> 6, d = col & 63;
                            *(f32x4*)(KM + (((size_t)(((u.pm >> 4) * 8 + h) * 16 + (u.pm & 15))) * 2 + wr) * 64 + d) = s; } }
            }
        } else {
            if (wc < 2) {
#pragma unroll
                for (int ai = 0; ai < 2; ++ai)
#pragma unroll
                    for (int m = 0; m < 4; ++m) { const float s = rs[ai][m]; const int row = row0 + ai * HALF + m * 16;
                        const f32x4 v0 = acc[ai][0][m][0] * s, v1 = acc[ai][0][m][1] * s;
                        u32x4 w; w.x = cvt_pk_bf16(v0[0], v0[1]); w.y = cvt_pk_bf16(v0[2], v0[3]); w.z = cvt_pk_bf16(v1[0], v1[1]); w.w = cvt_pk_bf16(v1[2], v1[3]);
                        *(u32x4*)(KIB + (size_t)row * 64 + wc * 32 + 8 * fq) = w;
                        float q = dot4(v0) + dot4(v1); q += __shfl_xor(q, 16); q += __shfl_xor(q, 32);
                        if (fq == 0) KISS[(size_t)row * 2 + wc] = q; }
            } else if (wc == 2 && fq < 2) {
#pragma unroll
                for (int ai = 0; ai < 2; ++ai)
#pragma unroll
                    for (int m = 0; m < 4; ++m) { const float s = rs[ai][m]; const int row = row0 + ai * HALF + m * 16;
                        *(f32x4*)(WI + (size_t)row * 16 + 8 * fq) = acc[ai][0][m][0] * s; *(f32x4*)(WI + (size_t)row * 16 + 8 * fq + 4) = acc[ai][0][m][1] * s; }
            }
        }
    }
};

struct EpiRes {
    static constexpr bool PERM = true, AFTER_DRAIN = false;
    const float* base; float* out; bf16_t* XB; float* SSo; PG8_LAS float* ex;
    __device__ __forceinline__ void operator()(const f32x4 (&acc)[2][2][4][2], const Unit& u, int wr, int wc, int fr_, int fq_) const {
        int fr = fr_, fq = fq_; asm volatile("" : "+v"(fr), "+v"(fq));
        const int row0 = u.pm * BM + wr * 64 + fr, col0 = u.pn * BM + wc * 32 + 8 * fq;
#pragma unroll
        for (int ai = 0; ai < 2; ++ai)
#pragma unroll
            for (int m = 0; m < 4; ++m) { const int row = row0 + ai * HALF + m * 16; const size_t off = (size_t)row * 1024 + col0; float q = 0.f;
#pragma unroll
                for (int bj = 0; bj < 2; ++bj) { const f32x4 b0 = *(const f32x4*)(base + off + bj * HALF), b1 = *(const f32x4*)(base + off + bj * HALF + 4);
                    const f32x4 x0 = b0 + acc[ai][bj][m][0], x1 = b1 + acc[ai][bj][m][1];
                    *(f32x4*)(out + off + bj * HALF) = x0; *(f32x4*)(out + off + bj * HALF + 4) = x1;
                    u32x4 w; w.x = cvt_pk_bf16(x0[0], x0[1]); w.y = cvt_pk_bf16(x0[2], x0[3]); w.z = cvt_pk_bf16(x1[0], x1[1]); w.w = cvt_pk_bf16(x1[2], x1[3]);
                    *(u32x4*)(XB + off + bj * HALF) = w; q += dot4(x0) + dot4(x1); }
                q += __shfl_xor(q, 16); q += __shfl_xor(q, 32);
                if (fq == 0) ex[(ai * HALF + wr * 64 + m * 16 + fr) * 4 + wc] = q; }
        asm volatile("s_waitcnt lgkmcnt(0)" ::: "memory"); __builtin_amdgcn_s_barrier(); asm volatile("" ::: "memory");
        const int t = (wr * 4 + wc) * 64 + fq * 16 + fr;
        if (t < 256) { const f32x4 p = *(const PG8_LAS f32x4*)(ex + t * 4); SSo[(size_t)(u.pm * BM + t) * 4 + u.pn] = (p[0] + p[1]) + (p[2] + p[3]); }
    }
};

struct EpiUp {
    static constexpr bool PERM = true, AFTER_DRAIN = false;
    bf16_t* G; float* UE; const float* SS; const float* cw; const float* cb; PG8_LAS float* ex;
    __device__ __forceinline__ void operator()(f32x4 (&acc)[2][2][4][2], const Unit& u, int wr, int wc, int fr_, int fq_) const {
        int fr = fr_, fq = fq_; asm volatile("" : "+v"(fr), "+v"(fq));
        const int row0 = u.pm * BM + wr * 64 + fr;
#pragma unroll
        for (int ai = 0; ai < 2; ++ai)
#pragma unroll
            for (int m = 0; m < 4; ++m) { const float s = row_rstd(SS, row0 + ai * HALF + m * 16);
#pragma unroll
                for (int bj = 0; bj < 2; ++bj)
#pragma unroll
                    for (int n = 0; n < 2; ++n) acc[ai][bj][m][n] *= s; }
        const int cidx = wc * 32 + 8 * fq;
        if (fr >= 14) {
#pragma unroll
            for (int ai = 0; ai < 2; ++ai) { PG8_LAS float* e = ex + ((ai * 2 + wr) * 2 + (fr - 14)) * 256 + cidx;
#pragma unroll
                for (int bj = 0; bj < 2; ++bj)
#pragma unroll
                    for (int n = 0; n < 2; ++n) *(PG8_LAS f32x4*)(e + bj * 128 + 4 * n) = acc[ai][bj][3][n]; }
        }
        float* ue = UE + (size_t)u.pm * 4 * NUP + u.pn * 256 + cidx;
        if (wr == 0 && fr < 2) {
#pragma unroll
            for (int bj = 0; bj < 2; ++bj)
#pragma unroll
                for (int n = 0; n < 2; ++n) *(f32x4*)(ue + (size_t)fr * NUP + bj * 128 + 4 * n) = acc[0][bj][0][n];
        }
        if (wr == 1 && fr >= 14) {
#pragma unroll
            for (int bj = 0; bj < 2; ++bj)
#pragma unroll
                for (int n = 0; n < 2; ++n) *(f32x4*)(ue + (size_t)(2 + fr - 14) * NUP + bj * 128 + 4 * n) = acc[1][bj][3][n];
        }
        asm volatile("s_waitcnt lgkmcnt(0)" ::: "memory"); __builtin_amdgcn_s_barrier(); asm volatile("" ::: "memory");
        const int ffc = u.pn * 128 + cidx;
#pragma unroll
        for (int n = 0; n < 2; ++n) {
            const int c = ffc + 4 * n;
            const f32x4 w0v = *(const f32x4*)(cw + c), w1v = *(const f32x4*)(cw + NUP + c), w2v = *(const f32x4*)(cw + 2 * NUP + c), bv = *(const f32x4*)(cb + c);
            const f32x4 w0g = *(const f32x4*)(cw + FF + c), w1g = *(const f32x4*)(cw + NUP + FF + c), w2g = *(const f32x4*)(cw + 2 * NUP + FF + c), bg = *(const f32x4*)(cb + FF + c);
#pragma unroll
            for (int ai = 0; ai < 2; ++ai) {
                const int pb = ai * 2 + wr - 1;
                f32x4 pv = {0.f, 0.f, 0.f, 0.f}, pg = {0.f, 0.f, 0.f, 0.f};
                if (pb >= 0 && fr >= 14) { const PG8_LAS float* e = ex + (pb * 2 + (fr - 14)) * 256 + cidx + 4 * n; pv = *(const PG8_LAS f32x4*)e; pg = *(const PG8_LAS f32x4*)(e + 128); }
#pragma unroll
                for (int m = 0; m < 4; ++m) {
                    const f32x4 uv = acc[ai][0][m][n], ug = acc[ai][1][m][n];
                    float g[4];
#pragma unroll
                    for (int j = 0; j < 4; ++j) {
                        const float cv = bv[j] + w0v[j] * shift2(uv[j], pv[j]) + w1v[j] * shift1(uv[j], pv[j]) + w2v[j] * uv[j];
                        const float cg = bg[j] + w0g[j] * shift2(ug[j], pg[j]) + w1g[j] * shift1(ug[j], pg[j]) + w2g[j] * ug[j];
                        g[j] = cv * cg * __builtin_amdgcn_rcpf(1.0f + __builtin_amdgcn_exp2f(-cg * 1.4426950408889634f));
                    }
                    typedef unsigned u32x2 __attribute__((ext_vector_type(2)));
                    u32x2 w; w.x = cvt_pk_bf16(g[0], g[1]); w.y = cvt_pk_bf16(g[2], g[3]);
                    *(u32x2*)(G + (size_t)(row0 + ai * HALF + m * 16) * FF + c) = w;
                    pv = uv; pg = ug;
                }
            }
        }
    }
};

template <class Epi, class Sched, bool ALIGN_EPI = false, bool SP2 = false>
__device__ __forceinline__ void gemm_phase(PG8_LAS unsigned char* lds, const Gemm g, const Sched& S, const Epi& E, const int wave_sgpr) {
    int tid_; asm volatile("v_mbcnt_lo_u32_b32 %0, -1, 0\n\tv_mbcnt_hi_u32_b32 %0, -1, %0" : "=v"(tid_)); tid_ += wave_sgpr * 64;
    const int tid = tid_, wid = __builtin_amdgcn_readfirstlane(tid >> 6), lane = tid & 63, wr = wid >> 2, wc = wid & 3, fr = lane & 15, fq = lane >> 4;
    const int K = g.K, nt = K / BK;
    unsigned voffA[2], voffB[2];
#pragma unroll
    for (int i = 0; i < 2; ++i) { int R, C; stage_rc(tid * 16 + i * 8192, R, C); const int Rb = Epi::PERM ? ((R & ~31) + perm32(R & 31)) : R;
        voffA[i] = (unsigned)(R * K + C) * 2u; voffB[i] = (unsigned)(Rb * K + C) * 2u; }
    const size_t kstep = (size_t)(BK * 2);
    const size_t hstep = (size_t)HALF * K * 2;
    const size_t tstep = 2 * hstep;
    const unsigned ldsw = (unsigned)wid * 1024u;
    const int aoff = lds_byte(wr * 64 + fr, fq * 8), boff = lds_byte(wc * 32 + fr, fq * 8);
#define PG8_SA(b, h) (((b) * 2 + (h)) * HTB)
#define PG8_SB(b, h) ((4 + (b) * 2 + (h)) * HTB)
#define PG8_STAGE(bufoff, gbase, voff) do { _Pragma("unroll") for (int _i = 0; _i < 2; ++_i) \
        __builtin_amdgcn_global_load_lds((const unsigned*)((const char*)(gbase) + (voff)[_i]), (PG8_LAS unsigned*)(lds + (bufoff) + ldsw + _i * 8192), 16, 0, 0); } while (0)
#define PG8_LDA(dst, b, h) do { _Pragma("unroll") for (int m = 0; m < 4; ++m) _Pragma("unroll") for (int k = 0; k < 2; ++k) dst[m][k] = *(const PG8_LAS bf16x8*)(lds + PG8_SA(b, h) + aoff + m * 2048 + k * 1024); } while (0)
#define PG8_LDB(dst, b, h) do { _Pragma("unroll") for (int n = 0; n < 2; ++n) _Pragma("unroll") for (int k = 0; k < 2; ++k) dst[n][k] = *(const PG8_LAS bf16x8*)(lds + PG8_SB(b, h) + boff + n * 2048 + k * 1024); } while (0)
#define PG8_MMA(ai, bj, At, Bt) do { __builtin_amdgcn_s_setprio(1); _Pragma("unroll") for (int m = 0; m < 4; ++m) _Pragma("unroll") for (int n = 0; n < 2; ++n) _Pragma("unroll") for (int k = 0; k < 2; ++k) \
        acc[ai][bj][m][n] = __builtin_amdgcn_mfma_f32_16x16x32_bf16(Bt[n][k], At[m][k], acc[ai][bj][m][n], 0, 0, 0); __builtin_amdgcn_s_setprio(0); } while (0)
#define PG8_WAIT_V(n) asm volatile("s_waitcnt vmcnt(" #n ")" ::: "memory")
#define PG8_WAIT_L(n) asm volatile("s_waitcnt lgkmcnt(" #n ")" ::: "memory")
#define PG8_BAR __builtin_amdgcn_s_barrier()
#define PG8_SCHED __builtin_amdgcn_sched_barrier(0)
    Unit cur, nxt; int ui = 0;
    if (!S.next(0, cur)) return;
    f32x4 acc[2][2][4][2];
#pragma unroll
    for (int a = 0; a < 2; ++a)
#pragma unroll
        for (int b = 0; b < 2; ++b)
#pragma unroll
            for (int m = 0; m < 4; ++m)
#pragma unroll
                for (int n = 0; n < 2; ++n) acc[a][b][m][n] = (f32x4){0.f, 0.f, 0.f, 0.f};
    bf16x8 At[4][2], B0[2][2], B1[2][2];
    const char* cA = (const char*)g.A + (size_t)cur.pm * tstep; const char* cB = (const char*)g.Bt + (size_t)cur.pn * tstep;
    S.a_ready(cur);
    if constexpr (SP2) {
        PG8_STAGE(PG8_SB(0, 0), cB, voffB); PG8_STAGE(PG8_SB(0, 1), cB + hstep, voffB); PG8_STAGE(PG8_SA(0, 0), cA, voffA); PG8_STAGE(PG8_SA(0, 1), cA + hstep, voffA);
        if (wr == 1) PG8_BAR;
        PG8_WAIT_V(2); PG8_BAR;
        PG8_STAGE(PG8_SB(1, 0), cB + kstep, voffB); PG8_STAGE(PG8_SA(1, 0), cA + kstep, voffA); PG8_STAGE(PG8_SB(1, 1), cB + hstep + kstep, voffB);
        PG8_WAIT_V(6); PG8_BAR;
    } else {
        PG8_STAGE(PG8_SB(0, 0), cB, voffB); PG8_STAGE(PG8_SA(0, 0), cA, voffA); PG8_STAGE(PG8_SB(0, 1), cB + hstep, voffB); PG8_STAGE(PG8_SA(0, 1), cA + hstep, voffA);
        if (wr == 1) PG8_BAR;
        PG8_WAIT_V(4); PG8_BAR;
        PG8_STAGE(PG8_SB(1, 0), cB + kstep, voffB); PG8_STAGE(PG8_SA(1, 0), cA + kstep, voffA); PG8_STAGE(PG8_SB(1, 1), cB + hstep + kstep, voffB);
        PG8_WAIT_V(6); PG8_BAR;
    }
    for (;;) {
        const bool has_next = S.next(ui + 1, nxt);
        const char* nA = has_next ? (const char*)g.A + (size_t)nxt.pm * tstep : cA; const char* nB = has_next ? (const char*)g.Bt + (size_t)nxt.pn * tstep : cB;
        for (int t = 0; t < nt; t += 2) {
            const bool last = (t == nt - 2);
            const char* a1 = cA + (size_t)(t + 1) * kstep;
            const char* a2 = last ? nA : cA + (size_t)(t + 2) * kstep; const char* b2 = last ? nB : cB + (size_t)(t + 2) * kstep;
            const char* a3 = a2 + kstep; const char* b3 = b2 + kstep;
            if (last && has_next) S.a_ready(nxt);
            if constexpr (SP2) {
            PG8_LDB(B0, 0, 0); PG8_LDB(B1, 0, 1); PG8_SCHED; PG8_LDA(At, 0, 0); PG8_STAGE(PG8_SA(1, 1), a1 + hstep, voffA);
            PG8_WAIT_V(8); PG8_WAIT_L(0); PG8_BAR; PG8_MMA(0, 0, At, B0); PG8_MMA(0, 1, At, B1); PG8_BAR; PG8_SCHED;
            PG8_LDA(At, 0, 1); PG8_STAGE(PG8_SB(0, 0), b2, voffB); PG8_STAGE(PG8_SB(0, 1), b2 + hstep, voffB); PG8_STAGE(PG8_SA(0, 0), a2, voffA);
            PG8_WAIT_V(8); PG8_WAIT_L(0); PG8_BAR; PG8_MMA(1, 0, At, B0); PG8_MMA(1, 1, At, B1); PG8_BAR; PG8_SCHED;
            PG8_LDB(B0, 1, 0); PG8_LDB(B1, 1, 1); PG8_SCHED; PG8_LDA(At, 1, 0); PG8_STAGE(PG8_SA(0, 1), a2 + hstep, voffA);
            PG8_WAIT_V(8); PG8_WAIT_L(0); PG8_BAR; PG8_MMA(0, 0, At, B0); PG8_MMA(0, 1, At, B1); PG8_BAR; PG8_SCHED;
            PG8_LDA(At, 1, 1); PG8_STAGE(PG8_SB(1, 0), b3, voffB); PG8_STAGE(PG8_SB(1, 1), b3 + hstep, voffB); PG8_STAGE(PG8_SA(1, 0), a3, voffA);
            PG8_WAIT_V(8); PG8_WAIT_L(0); PG8_BAR; PG8_MMA(1, 0, At, B0); PG8_MMA(1, 1, At, B1); PG8_BAR; PG8_SCHED;
            } else {
            PG8_LDB(B0, 0, 0); PG8_SCHED; PG8_LDA(At, 0, 0); PG8_STAGE(PG8_SA(1, 1), a1 + hstep, voffA);
            PG8_WAIT_L(8); PG8_BAR; PG8_WAIT_L(0); PG8_MMA(0, 0, At, B0); PG8_BAR; PG8_SCHED;
            PG8_LDB(B1, 0, 1); PG8_STAGE(PG8_SB(0, 0), b2, voffB);
            PG8_BAR; PG8_WAIT_L(0); PG8_MMA(0, 1, At, B1); PG8_BAR;
            PG8_LDA(At, 0, 1); PG8_STAGE(PG8_SA(0, 0), a2, voffA);
            PG8_BAR; PG8_WAIT_L(0); PG8_MMA(1, 0, At, B0); PG8_BAR; PG8_SCHED;
            PG8_STAGE(PG8_SB(0, 1), b2 + hstep, voffB);
            PG8_WAIT_V(6); PG8_BAR; PG8_MMA(1, 1, At, B1); PG8_BAR;
            PG8_LDB(B0, 1, 0); PG8_SCHED; PG8_LDA(At, 1, 0); PG8_STAGE(PG8_SA(0, 1), a2 + hstep, voffA);
            PG8_WAIT_L(8); PG8_BAR; PG8_WAIT_L(0); PG8_MMA(0, 0, At, B0); PG8_BAR; PG8_SCHED;
            PG8_LDB(B1, 1, 1); PG8_STAGE(PG8_SB(1, 0), b3, voffB);
            PG8_BAR; PG8_WAIT_L(0); PG8_MMA(0, 1, At, B1); PG8_BAR;
            PG8_LDA(At, 1, 1); PG8_STAGE(PG8_SA(1, 0), a3, voffA);
            PG8_BAR; PG8_WAIT_L(0); PG8_MMA(1, 0, At, B0); PG8_BAR; PG8_SCHED;
            PG8_STAGE(PG8_SB(1, 1), b3 + hstep, voffB);
            PG8_WAIT_V(6); PG8_BAR; PG8_MMA(1, 1, At, B1); PG8_BAR;
            }
        }
        if constexpr (ALIGN_EPI) { if (wr == 0) PG8_BAR; }
        if constexpr (!Epi::AFTER_DRAIN) { E(acc, cur, wr, wc, fr, fq); S.done(cur); }
        if (!has_next) break;
#pragma unroll
        for (int a = 0; a < 2; ++a)
#pragma unroll
            for (int b = 0; b < 2; ++b)
#pragma unroll
                for (int m = 0; m < 4; ++m)
#pragma unroll
                    for (int n = 0; n < 2; ++n) acc[a][b][m][n] = (f32x4){0.f, 0.f, 0.f, 0.f};
        cur = nxt; cA = nA; cB = nB; ++ui;
        if constexpr (ALIGN_EPI) { if (wr == 1) PG8_BAR; }
    }
    PG8_WAIT_V(0);
    if constexpr (!ALIGN_EPI) { if (wr == 0) PG8_BAR; }
    PG8_BAR;
    if constexpr (Epi::AFTER_DRAIN) { E.fused(acc, cur, wr, wc, fr, fq, lds, wid, lane); S.done(cur); }
#undef PG8_SA
#undef PG8_SB
#undef PG8_STAGE
#undef PG8_LDA
#undef PG8_LDB
#undef PG8_MMA
#undef PG8_WAIT_V
#undef PG8_WAIT_L
#undef PG8_BAR
#undef PG8_SCHED
}
}
#define GAS __attribute__((address_space(1)))
#define LAS __attribute__((address_space(3)))
typedef unsigned short bf16;
typedef unsigned v4u __attribute__((ext_vector_type(4)));
typedef float f32x4 __attribute__((ext_vector_type(4)));
typedef short bf16x8 __attribute__((ext_vector_type(8)));
typedef GAS unsigned gu32;
typedef GAS unsigned long long gu64;
#define RLX_AGENT __ATOMIC_RELAXED, __HIP_MEMORY_SCOPE_AGENT
#define LDS_WAIT() asm volatile("s_waitcnt lgkmcnt(0)" ::: "memory")
#define VM_WAIT() asm volatile("s_waitcnt vmcnt(0)" ::: "memory")
__device__ __forceinline__ unsigned long long rt() { return __builtin_amdgcn_s_memrealtime(); }
__device__ __forceinline__ unsigned f2bf(float f) { unsigned u = __builtin_bit_cast(unsigned, f); return (u + 0x7fffu + ((u >> 16) & 1u)) >> 16; }
__device__ __forceinline__ unsigned pk2(float lo, float hi) { return f2bf(lo) | (f2bf(hi) << 16); }

#define XB_TMO      128
#define XB_XCNT(j)  (256  + 64 * (j))
#define XB_XSUB(j)  (1280 + 64 * (j))
#define XB_XGEN(j)  (2304 + 64 * (j))
#define XB_TOP      3328
#define XB_TOPGEN   3392
#define XCD_BAR_WORDS 3456
#define XB_SPIN_CAP (1u << 18)

__device__ __forceinline__ unsigned xb_ld(unsigned* p)              { return __hip_atomic_load(p, __ATOMIC_RELAXED, __HIP_MEMORY_SCOPE_AGENT); }
__device__ __forceinline__ unsigned xb_add(unsigned* p, unsigned v) { return __hip_atomic_fetch_add(p, v, __ATOMIC_RELAXED, __HIP_MEMORY_SCOPE_AGENT); }
__device__ __forceinline__ unsigned xb_xcc_id() { return (unsigned)__builtin_amdgcn_s_getreg((3 << 11) | 20) & 0xFu; }
#define XB_SPIN(cond, bar) do { unsigned _sp = 0; while (cond) { __builtin_amdgcn_s_sleep(1); \
    if ((++_sp & 255u) == 0u) { if (xb_ld(&(bar)[XB_TMO])) break; if (_sp > XB_SPIN_CAP) { atomicAdd(&(bar)[XB_TMO], 1u); break; } } } } while (0)

__device__ __forceinline__ int hw_lane() { int l; asm volatile("v_mbcnt_lo_u32_b32 %0, -1, 0\n\tv_mbcnt_hi_u32_b32 %0, -1, %0" : "=v"(l)); return l; }
struct XcdBarrier {
    int wave; unsigned* bar; unsigned x;
    volatile LAS unsigned* st;
};

__device__ __forceinline__ XcdBarrier xcd_barrier_post(unsigned* bar, volatile LAS unsigned* st, int wave) {
    XcdBarrier b; b.bar = bar; b.x = xb_xcc_id(); b.st = st; b.wave = wave;
    if (wave == 0 && hw_lane() == 0) (void)xb_add(&bar[XB_XCNT(b.x)], 1u);
    return b;
}
__device__ __forceinline__ void xcd_barrier_complete(unsigned* bar, unsigned x, unsigned& nloc, unsigned& nx) {
    const unsigned G = gridDim.x * gridDim.y * gridDim.z;
    unsigned sum, cnt, mine, sp = 0u;
    for (;;) {
        sum = 0u; cnt = 0u; mine = 0u;
#pragma unroll
        for (unsigned j = 0; j < 16; ++j) { const unsigned c = xb_ld(&bar[XB_XCNT(j)]); sum += c; cnt += (c > 0u) ? 1u : 0u; mine = (j == x) ? c : mine; }
        if (sum == G) break;
        __builtin_amdgcn_s_sleep(1);
        if ((++sp & 255u) == 0u) { if (xb_ld(&bar[XB_TMO])) break; if (sp > XB_SPIN_CAP) { atomicAdd(&bar[XB_TMO], 1u); break; } }
    }
    nloc = mine > 0u ? mine : 1u; nx = cnt > 0u ? cnt : 1u;
}

__device__ __forceinline__ unsigned xb_xcc_id_v() { unsigned r; asm volatile("s_getreg_b32 %0, hwreg(20, 0, 4)" : "=s"(r)); return r & 0xFu; }
__device__ __forceinline__ void xcd_barrier(const XcdBarrier& b_) {
    XcdBarrier b; { unsigned* bp = b_.bar; asm volatile("" : "+s"(bp)); b.bar = bp; } b.st = b_.st; b.wave = b_.wave; b.x = xb_xcc_id_v();
    asm volatile("s_waitcnt vmcnt(0)" ::: "memory");
    __syncthreads();
    if (b.wave == 0 && hw_lane() == 0) {
        unsigned* bar = b.bar;
        __builtin_amdgcn_s_waitcnt(0);
        unsigned nloc = b.st[0], nx = b.st[1];
        if (nloc == 0u) { xcd_barrier_complete(bar, b.x, nloc, nx); b.st[0] = nloc; b.st[1] = nx; }
        const unsigned old = xb_add(&bar[XB_XSUB(b.x)], 1u);
        const unsigned gen = old / nloc;
        if (old + 1u == (gen + 1u) * nloc) {
            __builtin_amdgcn_fence(__ATOMIC_RELEASE, "agent");
            asm volatile("s_waitcnt vmcnt(0)" ::: "memory");
            const unsigned og = xb_add(&bar[XB_TOP], 1u);
            const unsigned tg = og / nx;
            if (og + 1u == (tg + 1u) * nx) xb_add(&bar[XB_TOPGEN], 1u);
            else XB_SPIN(xb_ld(&bar[XB_TOPGEN]) == tg, bar);
            __builtin_amdgcn_fence(__ATOMIC_ACQUIRE, "agent");
            xb_add(&bar[XB_XGEN(b.x)], 1u);
            asm volatile("s_waitcnt vmcnt(0)" ::: "memory");
        } else {
            XB_SPIN(xb_ld(&bar[XB_XGEN(b.x)]) == gen, bar);
            __builtin_amdgcn_fence(__ATOMIC_ACQUIRE, "agent");
            asm volatile("s_waitcnt vmcnt(0)" ::: "memory");
        }
    }
    __syncthreads();
}

constexpr size_t MiB = 1u << 20;
constexpr size_t WS_BAR = 0, BAR_ZERO_BYTES = 65536;
constexpr size_t WS_SS = 1 * MiB;
constexpr size_t WS_KM = 3 * MiB;
constexpr size_t WS_KISS = 3 * MiB + 512 * 1024;
constexpr size_t WS_WI = 4 * MiB;
constexpr size_t WS_KIB = 5 * MiB;
constexpr size_t WS_UE = 7 * MiB;
constexpr size_t WS_MASK = 13 * MiB;
constexpr size_t WS_WIN = 21 * MiB, WS_WO = 30 * MiB, WS_WUP = 32 * MiB, WS_WDN = 43 * MiB;
constexpr size_t WS_XB = 54 * MiB;
constexpr size_t WS_Q = 86 * MiB, WS_K = 118 * MiB, WS_V = 150 * MiB, WS_QI = 182 * MiB;
constexpr size_t WS_G = 118 * MiB;
constexpr size_t WS_END = 214 * MiB;
static_assert(WS_G + (size_t)M * FF * 2 <= WS_END && WS_WDN + 2 * (size_t)D * FF * 2 <= WS_XB && WS_WUP + (size_t)NUP * D * 2 <= WS_WDN && WS_WIN + (size_t)NIN_E * D * 2 <= WS_WO, "d_ws map");
static_assert(WS_UE + (size_t)64 * 4 * NUP * 4 <= WS_MASK && WS_MASK + (size_t)M * 64 * 8 <= WS_WIN, "d_ws map 2");

constexpr int RING_OFF = 0, RING_BYTES = 131072;
constexpr int AUX_OFF = 131072, AUX_BYTES = 16384;
constexpr int LDSCTL_OFF = AUX_OFF + AUX_BYTES, MISC_OFF = LDSCTL_OFF + 320;
constexpr int LDS_BYTES = 151552;
constexpr int NWAVES = 8;

struct Frame {
    LAS unsigned char* lds;
    volatile LAS unsigned* MISC;
    int tid, lane, wave, G, vcu;
    float* out; unsigned char* ws;
};
struct Args { const float* in[13]; float* out; unsigned char* ws; };
#define RELAUNDER(F) do { int l_ = hw_lane(); asm volatile("" : "+v"(l_)); (F).lane = l_; (F).tid = (F).wave * 64 + l_; \
    unsigned char* w_ = args.ws; asm volatile("" : "+s"(w_)); (F).ws = w_; } while (0)

__device__ __forceinline__ float wave_sum(float v) {
#pragma unroll
    for (int o = 1; o < 64; o <<= 1) v += __shfl_xor(v, o);
    return v;
}
__device__ __forceinline__ float wave_max(float v) {
#pragma unroll
    for (int o = 1; o < 64; o <<= 1) v = fmaxf(v, __shfl_xor(v, o));
    return v;
}
__device__ __forceinline__ int t5_bucket(int d) {
    if (d < 16) return d;
    int b = 16;
    b += (d >= 19); b += (d >= 21); b += (d >= 24); b += (d >= 27); b += (d >= 31); b += (d >= 35); b += (d >= 40); b += (d >= 46);
    b += (d >= 52); b += (d >= 59); b += (d >= 67); b += (d >= 77); b += (d >= 87); b += (d >= 99); b += (d >= 113);
    return b;
}

__device__ __forceinline__ void tr_item(const float* W, int ldn, int scol0, int nvalid, int k0, const float* gk, const float* sn, bf16* WT, int Kd, int drow0, LAS float* scr, int lane) {
    const int c32 = lane & 31;
#pragma unroll 8
    for (int i = 0; i < 32; ++i) { const int kk = 2 * i + (lane >> 5);
        float v = 0.f; if (c32 < nvalid) { v = W[(size_t)(k0 + kk) * ldn + scol0 + c32]; if (gk) v *= gk[k0 + kk]; }
        scr[kk * 33 + c32] = v; }
    LDS_WAIT(); asm volatile("" ::: "memory");
    const int c = lane & 7;
#pragma unroll
    for (int j = 0; j < 4; ++j) { const int n = (lane >> 3) + 8 * j; const LAS float* s = scr + (8 * c) * 33 + n; const float f = sn ? sn[(drow0 + n) & 63] : 1.f;
        v4u o; o.x = pk2(s[0 * 33] * f, s[1 * 33] * f); o.y = pk2(s[2 * 33] * f, s[3 * 33] * f); o.z = pk2(s[4 * 33] * f, s[5 * 33] * f); o.w = pk2(s[6 * 33] * f, s[7 * 33] * f);
        *(GAS v4u*)(WT + (size_t)(drow0 + n) * Kd + k0 + 8 * c) = o; }
    LDS_WAIT(); asm volatile("" ::: "memory");
}
__device__ __forceinline__ void convert_layer(Frame& F, const Args& A, int L) {
    LAS float* scr = (LAS float*)(F.lds + RING_OFF + F.wave * 16384);
    const int gw = F.vcu * NWAVES + F.wave, NGW = F.G * NWAVES;
    const int j = L >> 1; const bool even = !(L & 1);
    const int nb_in = even ? NIN_E / 32 : NIN_O / 32;
    const int I_IN = 16 * nb_in, I_O = 16 * 32, I_UP = 16 * (NUP / 32), I_DN = (FF / 64) * (D / 32);
    const int NIT = I_IN + I_O + I_UP + I_DN;
    bf16* WinT = (bf16*)(F.ws + WS_WIN); bf16* WoT = (bf16*)(F.ws + WS_WO); bf16* WupT = (bf16*)(F.ws + WS_WUP); bf16* WdnT = (bf16*)(F.ws + WS_WDN) + (size_t)(L & 1) * D * FF;
    for (int it = gw; it < NIT; it += NGW) {
        int r = it;
        if (r < I_IN) {
            const int kb = r / nb_in, nb = r % nb_in, dr = 32 * nb;
            if (even) {
                int sc0, nv = 32; const float* sn = nullptr;
                if (dr < 512) sc0 = dr; else if (dr < 1024) sc0 = 1536 + (dr - 512); else if (dr < 1536) sc0 = 512 + (dr - 1024); else if (dr < 2048) sc0 = 2048 + (dr - 1536);
                else if (dr < 2560) sc0 = 1024 + (dr - 2048); else if (dr < 3072) sc0 = 2560 + (dr - 2560); else if (dr < 4096) { sc0 = dr; sn = A.in[2] + j * 64; }
                else if (dr < 4160) sc0 = dr; else if (dr == 4160) { sc0 = 4160; nv = 16; } else { sc0 = 0; nv = 0; }
                tr_item(A.in[1] + (size_t)j * D * EVEN_IN, EVEN_IN, sc0, nv, 64 * kb, A.in[6] + L * D, sn, WinT, D, dr, scr, F.lane);
            } else {
                tr_item(A.in[3] + (size_t)j * D * NIN_O, NIN_O, dr, 32, 64 * kb, A.in[6] + L * D, nullptr, WinT, D, dr, scr, F.lane);
            }
            continue;
        }
        r -= I_IN;
        if (r < I_O) { const int kb = r / 32, nb = r % 32; tr_item(A.in[4] + (size_t)L * D * D, D, 32 * nb, 32, 64 * kb, nullptr, nullptr, WoT, D, 32 * nb, scr, F.lane); continue; }
        r -= I_O;
        if (r < I_UP) { const int kb = r / (NUP / 32), nb = r % (NUP / 32); const int p = nb >> 3, half = (nb >> 2) & 1, c0 = (nb & 3) * 32;
            tr_item(A.in[8] + (size_t)L * D * NUP, NUP, half * FF + 128 * p + c0, 32, 64 * kb, A.in[7] + L * D, nullptr, WupT, D, 32 * nb, scr, F.lane); continue; }
        r -= I_UP;
        { const int kb = r / 32, nb = r % 32; tr_item(A.in[11] + (size_t)L * FF * D, D, 32 * nb, 32, 64 * kb, nullptr, nullptr, WdnT, FF, 32 * nb, scr, F.lane); }
    }
}
__device__ __forceinline__ void p0_prologue(Frame& F, const Args& A) {
    const int gw = F.vcu * NWAVES + F.wave, NGW = F.G * NWAVES;
    const float* x = A.in[0]; bf16* XB = (bf16*)(F.ws + WS_XB); float* SS0 = (float*)(F.ws + WS_SS) + (size_t)M * 4;
    for (int m = gw; m < M; m += NGW) {
        const GAS f32x4* xr = (const GAS f32x4*)(x + (size_t)m * D) + F.lane;
        f32x4 v[4]; float s = 0.f;
#pragma unroll
        for (int jj = 0; jj < 4; ++jj) { v[jj] = xr[64 * jj]; s += (v[jj].x * v[jj].x + v[jj].y * v[jj].y) + (v[jj].z * v[jj].z + v[jj].w * v[jj].w); }
        s = wave_sum(s);
        if (F.lane < 4) SS0[(size_t)m * 4 + F.lane] = F.lane == 0 ? s : 0.f;
        GAS unsigned long long* o8 = (GAS unsigned long long*)(XB + (size_t)m * D) + F.lane;
#pragma unroll
        for (int jj = 0; jj < 4; ++jj) o8[64 * jj] = (unsigned long long)pk2(v[jj].x, v[jj].y) | ((unsigned long long)pk2(v[jj].z, v[jj].w) << 32);
    }
    convert_layer(F, A, 0);
}
__device__ __forceinline__ void final_norm(Frame& F, const Args& A) {
    const int gw = F.vcu * NWAVES + F.wave, NGW = F.G * NWAVES;
    const float* SS = (const float*)(F.ws + WS_SS) + (size_t)M * 4; const GAS f32x4* g4 = (const GAS f32x4*)A.in[12] + F.lane;
    f32x4 g[4];
#pragma unroll
    for (int jj = 0; jj < 4; ++jj) g[jj] = g4[64 * jj];
    for (int m = gw; m < M; m += NGW) {
        GAS f32x4* xr = (GAS f32x4*)(F.out + (size_t)m * D) + F.lane;
        const float rs = pg8::row_rstd(SS, m);
#pragma unroll
        for (int jj = 0; jj < 4; ++jj) { f32x4 v = xr[64 * jj]; v = v * rs * g[jj]; xr[64 * jj] = v; }
    }
}
__device__ __forceinline__ void fix_rows(Frame& F, const Args& A, int pm, int L) {
    const float* UE = (const float*)(F.ws + WS_UE); bf16* G = (bf16*)(F.ws + WS_G);
    const float* cw = A.in[9] + (size_t)L * 3 * NUP; const float* cb = A.in[10] + (size_t)L * NUP;
    const float* um2 = UE + ((size_t)(pm - 1) * 4 + 2) * NUP; const float* um1 = um2 + NUP; const float* u0 = UE + (size_t)pm * 4 * NUP; const float* u1 = u0 + NUP;
    for (int c = F.tid; c < FF; c += NWAVES * 64) {
        const int iv = (c >> 7) * 256 + (c & 127), ig = iv + 128;
        const float w0v = cw[c], w1v = cw[NUP + c], w2v = cw[2 * NUP + c], bv = cb[c], w0g = cw[FF + c], w1g = cw[NUP + FF + c], w2g = cw[2 * NUP + FF + c], bg = cb[FF + c];
        const float a2v = um2[iv], a1v = um1[iv], a0v = u0[iv], b0v = u1[iv], a2g = um2[ig], a1g = um1[ig], a0g = u0[ig], b0g = u1[ig];
        float cv = bv + w0v * a2v + w1v * a1v + w2v * a0v, cg = bg + w0g * a2g + w1g * a1g + w2g * a0g;
        float g0 = cv * cg * __builtin_amdgcn_rcpf(1.0f + __builtin_amdgcn_exp2f(-cg * LOG2E));
        cv = bv + w0v * a1v + w1v * a0v + w2v * b0v; cg = bg + w0g * a1g + w1g * a0g + w2g * b0g;
        float g1 = cv * cg * __builtin_amdgcn_rcpf(1.0f + __builtin_amdgcn_exp2f(-cg * LOG2E));
        G[(size_t)(pm * 256) * FF + c] = (bf16)f2bf(g0); G[(size_t)(pm * 256 + 1) * FF + c] = (bf16)f2bf(g1);
    }
}

typedef __bf16 bf16x2_t __attribute__((ext_vector_type(2)));
__device__ __forceinline__ float dot2bf(unsigned a, unsigned b, float c) { return __builtin_amdgcn_fdot2_f32_bf16(__builtin_bit_cast(bf16x2_t, a), __builtin_bit_cast(bf16x2_t, b), c, false); }
__device__ __forceinline__ float bflo(unsigned w) { return __uint_as_float(w << 16); }
__device__ __forceinline__ float bfhi(unsigned w) { return __uint_as_float(w & 0xffff0000u); }
struct LaneAcc { float m, l; f32x4 o[16]; };
__device__ __forceinline__ void la_init(LaneAcc& A) { A.m = -INFINITY; A.l = 0.f;
#pragma unroll
    for (int i = 0; i < 16; ++i) A.o[i] = (f32x4){0.f, 0.f, 0.f, 0.f}; }
__device__ __forceinline__ void la_key(LaneAcc& A, const v4u (&q)[8], const bf16* krow, const bf16* vrow, float bias2) {
    v4u k[8];
#pragma unroll
    for (int i = 0; i < 8; ++i) k[i] = *(const GAS v4u*)(krow + 8 * i);
    float s0 = 0.f, s1 = 0.f, s2 = 0.f, s3 = 0.f;
#pragma unroll
    for (int i = 0; i < 8; ++i) { s0 = dot2bf(q[i].x, k[i].x, s0); s1 = dot2bf(q[i].y, k[i].y, s1); s2 = dot2bf(q[i].z, k[i].z, s2); s3 = dot2bf(q[i].w, k[i].w, s3); }
    const float s = (s0 + s1) + (s2 + s3) + bias2;
    if (s > A.m) { const float f = __builtin_amdgcn_exp2f(A.m - s); A.l *= f;
#pragma unroll
        for (int i = 0; i < 16; ++i) A.o[i] *= f;
        A.m = s; }
    const float p = __builtin_amdgcn_exp2f(s - A.m); A.l += p;
    v4u v[8];
#pragma unroll
    for (int i = 0; i < 8; ++i) v[i] = *(const GAS v4u*)(vrow + 8 * i);
#pragma unroll
    for (int i = 0; i < 8; ++i) {
        A.o[2 * i] += p * (f32x4){bflo(v[i].x), bfhi(v[i].x), bflo(v[i].y), bfhi(v[i].y)};
        A.o[2 * i + 1] += p * (f32x4){bflo(v[i].z), bfhi(v[i].z), bflo(v[i].w), bfhi(v[i].w)};
    }
}
__device__ __forceinline__ void la_finish(LaneAcc& A, bf16* orow, int lane) {
    const float Mx = wave_max(A.m);
    const float f = (A.m == -INFINITY) ? 0.f : __builtin_amdgcn_exp2f(A.m - Mx);
    const float Lt = wave_sum(A.l * f); const float inv = 1.0f / Lt;
#pragma unroll
    for (int i = 0; i < 16; ++i) { f32x4 t = A.o[i] * f; t[0] = wave_sum(t[0]); t[1] = wave_sum(t[1]); t[2] = wave_sum(t[2]); t[3] = wave_sum(t[3]); A.o[i] = t * inv; }
    if (lane == 0) {
#pragma unroll
        for (int i = 0; i < 8; ++i) { v4u w; w.x = pk2(A.o[2 * i][0], A.o[2 * i][1]); w.y = pk2(A.o[2 * i][2], A.o[2 * i][3]); w.z = pk2(A.o[2 * i + 1][0], A.o[2 * i + 1][1]); w.w = pk2(A.o[2 * i + 1][2], A.o[2 * i + 1][3]);
            *(GAS v4u*)(orow + 8 * i) = w; }
    }
}
__device__ __forceinline__ float rel_bias2(const float* rb, int h, int d) { return rb[t5_bucket(d) * 16 + h] * LOG2E; }

__device__ __forceinline__ void simple_moba(Frame& F, const Args& A, int layer_j) {
    const int gw = F.vcu * NWAVES + F.wave, NGW = F.G * NWAVES, lane = F.lane;
    bf16* Q = (bf16*)(F.ws + WS_Q); const bf16* K = (const bf16*)(F.ws + WS_K); const bf16* V = (const bf16*)(F.ws + WS_V);
    const float* KM = (const float*)(F.ws + WS_KM); const float* rb = A.in[5];
    for (int task = gw; task < M * 8; task += NGW) {
        const int h = task & 7, row = task >> 3, b = row >> 12, t = row & 4095, own = t >> 8;
        bf16* qrow = Q + (size_t)row * D + h * HD;
        v4u q[8];
#pragma unroll
        for (int i = 0; i < 8; ++i) q[i] = *(const GAS v4u*)(qrow + 8 * i);
        float g = -INFINITY;
        if (lane < own) { const GAS f32x4* km = (const GAS f32x4*)(KM + ((size_t)((b * 8 + h) * 16 + lane)) * 128); float a = 0.f;
#pragma unroll
            for (int i = 0; i < 8; ++i) { const f32x4 k0 = km[2 * i] + km[16 + 2 * i], k1 = km[2 * i + 1] + km[16 + 2 * i + 1];
                a += bflo(q[i].x) * k0[0] + bfhi(q[i].x) * k0[1] + bflo(q[i].y) * k0[2] + bfhi(q[i].y) * k0[3] + bflo(q[i].z) * k1[0] + bfhi(q[i].z) * k1[1] + bflo(q[i].w) * k1[2] + bfhi(q[i].w) * k1[3]; }
            g = a; }
        int sel0 = -1, sel1 = -1, sel2 = -1, nsel = 0;
#pragma unroll
        for (int r = 0; r < 3; ++r) { const float mx = wave_max(g);
            if (mx > -INFINITY) { const unsigned long long bal = __ballot(g == mx); const int idx = __ffsll((long long)bal) - 1;
                if (r == 0) sel0 = idx; else if (r == 1) sel1 = idx; else sel2 = idx; nsel = r + 1; if (lane == idx) g = -INFINITY; } }
        const int nown = t - own * 256 + 1, ntot = nsel * 256 + nown;
        LaneAcc A; la_init(A);
        for (int e = lane; e < ntot; e += 64) {
            const int bi = e >> 8; const int blk = bi < nsel ? (bi == 0 ? sel0 : (bi == 1 ? sel1 : sel2)) : own;
            const int s = blk * 256 + (e & 255); const size_t kr = (size_t)(b * SEQ + s) * D + h * HD;
            la_key(A, q, K + kr, V + kr, rel_bias2(rb, h, t - s));
        }
        la_finish(A, qrow, lane);
    }
}
__device__ __forceinline__ void simple_dsa(Frame& F, const Args& A) {
    const int gw = F.vcu * NWAVES + F.wave, NGW = F.G * NWAVES, lane = F.lane;
    bf16* Q = (bf16*)(F.ws + WS_Q); const bf16* K = (const bf16*)(F.ws + WS_K); const bf16* V = (const bf16*)(F.ws + WS_V);
    const unsigned long long* MASK = (const unsigned long long*)(F.ws + WS_MASK); const float* rb = A.in[5];
    for (int task = gw; task < M * 8; task += NGW) {
        const int h = 8 + (task & 7), row = task >> 3, b = row >> 12, t = row & 4095;
        bf16* qrow = Q + (size_t)row * D + h * HD;
        v4u q[8];
#pragma unroll
        for (int i = 0; i < 8; ++i) q[i] = *(const GAS v4u*)(qrow + 8 * i);
        unsigned long long w = MASK[(size_t)row * 64 + lane];
        LaneAcc A; la_init(A);
        while (w) { const int bit = __ffsll((long long)w) - 1; w &= w - 1; const int s = lane * 64 + bit;
            if (s <= t) { const size_t kr = (size_t)(b * SEQ + s) * D + h * HD; la_key(A, q, K + kr, V + kr, rel_bias2(rb, h, t - s)); } }
        la_finish(A, qrow, lane);
    }
}
__device__ __forceinline__ void simple_dilated(Frame& F, const Args& A) {
    const int gw = F.vcu * NWAVES + F.wave, NGW = F.G * NWAVES, lane = F.lane;
    bf16* Q = (bf16*)(F.ws + WS_Q); const bf16* K = (const bf16*)(F.ws + WS_K); const bf16* V = (const bf16*)(F.ws + WS_V); const float* rb = A.in[5];
    for (int task = gw; task < M * 16; task += NGW) {
        const int h = task & 15, row = task >> 4, b = row >> 12, t = row & 4095;
        bf16* qrow = Q + (size_t)row * D + h * HD;
        v4u q[8];
#pragma unroll
        for (int i = 0; i < 8; ++i) q[i] = *(const GAS v4u*)(qrow + 8 * i);
        LaneAcc A; la_init(A);
        for (int e = lane; e < 387; e += 64) { const int p = e / 129, i = e - 129 * p, d = i << (2 * p), s = t - d;
            if (s >= 0) { const size_t kr = (size_t)(b * SEQ + s) * D + h * HD; la_key(A, q, K + kr, V + kr, rel_bias2(rb, h, d)); } }
        la_finish(A, qrow, lane);
    }
}
__device__ __forceinline__ unsigned f2key(float f) { const unsigned u = __float_as_uint(f); return (u & 0x80000000u) ? ~u : (u | 0x80000000u); }
__device__ __forceinline__ void simple_indexer(Frame& F, int layer_j) {
    const int gw = F.vcu * NWAVES + F.wave, NGW = F.G * NWAVES, lane = F.lane;
    const bf16* QI = (const bf16*)(F.ws + WS_QI); const bf16* KIB = (const bf16*)(F.ws + WS_KIB); const float* WI = (const float*)(F.ws + WS_WI);
    const float* KISS = (const float*)(F.ws + WS_KISS); unsigned long long* MASK = (unsigned long long*)(F.ws + WS_MASK);
    LAS float* sc = (LAS float*)(F.lds + RING_OFF) + F.wave * 4096;
    LAS v4u* qs = (LAS v4u*)(F.lds + AUX_OFF + F.wave * 2048);
    LAS unsigned* hist = (LAS unsigned*)(F.lds + AUX_OFF + F.wave * 2048);
    for (int row = gw; row < M; row += NGW) {
        const int b = row >> 12, t = row & 4095, nj = (t >> 6) + 1;
        { const GAS v4u* src = (const GAS v4u*)(QI + (size_t)row * D); qs[lane] = src[lane]; qs[64 + lane] = src[64 + lane]; }
        f32x4 w4[4];
#pragma unroll
        for (int i = 0; i < 4; ++i) w4[i] = *(const GAS f32x4*)(WI + (size_t)row * 16 + 4 * i);
        LDS_WAIT(); asm volatile("" ::: "memory");
        for (int jj = 0; jj < nj; ++jj) {
            const int s = jj * 64 + lane; const size_t kr = (size_t)(b * SEQ + s);
            v4u k[8];
#pragma unroll
            for (int i = 0; i < 8; ++i) k[i] = *(const GAS v4u*)(KIB + kr * 64 + 8 * i);
            float score = 0.f;
#pragma unroll
            for (int h = 0; h < 16; ++h) { float a0 = 0.f, a1 = 0.f;
#pragma unroll
                for (int i = 0; i < 8; ++i) { const v4u qq = qs[h * 8 + i]; a0 = dot2bf(qq.x, k[i].x, a0); a1 = dot2bf(qq.y, k[i].y, a1); a0 = dot2bf(qq.z, k[i].z, a0); a1 = dot2bf(qq.w, k[i].w, a1); }
                score += fmaxf(a0 + a1, 0.f) * w4[h >> 2][h & 3]; }
            score *= __builtin_amdgcn_rsqf((KISS[kr * 2] + KISS[kr * 2 + 1]) * (1.0f / 64.0f) + RMS_EPS);
            sc[s] = (s <= t) ? score : -INFINITY;
        }
        LDS_WAIT(); asm volatile("" ::: "memory");
        unsigned thr = 0u; int need_eq = 0x7fffffff;
        if (t + 1 > 256) {
            unsigned prefix = 0u; int kk = 256;
#pragma unroll 1
            for (int pass = 0; pass < 4; ++pass) { const int sh = 24 - 8 * pass;
                hist[lane] = 0u; hist[64 + lane] = 0u; hist[128 + lane] = 0u; hist[192 + lane] = 0u;
                LDS_WAIT(); asm volatile("" ::: "memory");
                for (int jj = 0; jj < nj; ++jj) { const int s = jj * 64 + lane; const unsigned key = f2key(sc[s]);
                    const bool in = (s <= t) && (pass == 0 || (key >> (sh + 8)) == prefix);
                    if (in) __hip_atomic_fetch_add(hist + ((key >> sh) & 255u), 1u, __ATOMIC_RELAXED, __HIP_MEMORY_SCOPE_WORKGROUP); }
                LDS_WAIT(); asm volatile("" ::: "memory");
                const unsigned c0 = hist[4 * lane], c1 = hist[4 * lane + 1], c2 = hist[4 * lane + 2], c3 = hist[4 * lane + 3];
                const int ls = (int)(c0 + c1 + c2 + c3);
                int suf = ls;
#pragma unroll
                for (int o = 1; o < 64; o <<= 1) { const int v = __shfl_down(suf, o); if (lane + o < 64) suf += v; }
                const int above = suf - ls;
                const bool mine = (above < kk) && (suf >= kk);
                const unsigned long long bal = __ballot(mine); const int src = __ffsll((long long)bal) - 1;
                int bsel = 0, krem = kk;
                { int acc = above; if (acc + (int)c3 >= kk) { bsel = 3; krem = kk - acc; } else { acc += (int)c3; if (acc + (int)c2 >= kk) { bsel = 2; krem = kk - acc; } else { acc += (int)c2;
                      if (acc + (int)c1 >= kk) { bsel = 1; krem = kk - acc; } else { acc += (int)c1; bsel = 0; krem = kk - acc; } } } }
                bsel = __shfl(bsel + 4 * lane, src); krem = __shfl(krem, src);
                prefix = (prefix << 8) | (unsigned)bsel; kk = krem;
                LDS_WAIT(); asm volatile("" ::: "memory");
            }
            thr = prefix; need_eq = kk;
        }
        unsigned long long myword = 0ull;
        for (int jj = 0; jj < nj; ++jj) { const int s = jj * 64 + lane; const unsigned key = f2key(sc[s]); const bool valid = s <= t;
            unsigned long long gt = __ballot(valid && (t + 1 <= 256 || key > thr));
            if (t + 1 > 256 && need_eq > 0) { unsigned long long eq = __ballot(valid && key == thr); int c = __popcll(eq);
                while (c > need_eq) { eq &= ~(1ull << (63 - __clzll((long long)eq))); --c; }
                gt |= eq; need_eq -= c; }
            if (lane == jj) myword = gt; }
        MASK[(size_t)row * 64 + lane] = myword;
        LDS_WAIT(); asm volatile("" ::: "memory");
    }
}

__global__ void __launch_bounds__(NWAVES * 64, 2) mk_fwd(Args args) {
    extern __shared__ __attribute__((aligned(16))) unsigned char lds[];
    Frame F;
    F.lds = (LAS unsigned char*)lds;
    F.MISC = (volatile LAS unsigned*)(F.lds + MISC_OFF);
    F.wave = __builtin_amdgcn_readfirstlane(threadIdx.x >> 6); F.lane = hw_lane(); F.tid = F.wave * 64 + F.lane;
    F.G = gridDim.x; { const int bx = blockIdx.x; F.vcu = (F.G % 8 == 0) ? (bx % 8) * (F.G / 8) + bx / 8 : bx; }
    F.out = args.out; F.ws = args.ws;
    for (int u = F.tid; u < (LDS_BYTES - LDSCTL_OFF) / 4; u += NWAVES * 64) ((LAS unsigned*)(F.lds + LDSCTL_OFF))[u] = 0u;
    __syncthreads();
    XcdBarrier bar = xcd_barrier_post((unsigned*)(F.ws + WS_BAR), F.MISC + 8, F.wave);
#define GRID_BAR() xcd_barrier(bar)
#define PHASE_PTRS() RELAUNDER(F); unsigned char* ws = F.ws; \
    pg8::bf16_t* XB = (pg8::bf16_t*)(ws + WS_XB); pg8::bf16_t* Qb = (pg8::bf16_t*)(ws + WS_Q); pg8::bf16_t* Kb = (pg8::bf16_t*)(ws + WS_K); pg8::bf16_t* Vb = (pg8::bf16_t*)(ws + WS_V); \
    pg8::bf16_t* QIb = (pg8::bf16_t*)(ws + WS_QI); pg8::bf16_t* KIBb = (pg8::bf16_t*)(ws + WS_KIB); pg8::bf16_t* Gb = (pg8::bf16_t*)(ws + WS_G); float* SS = (float*)(ws + WS_SS); \
    (void)XB; (void)Qb; (void)Kb; (void)Vb; (void)QIb; (void)KIBb; (void)Gb; (void)SS

    p0_prologue(F, args); GRID_BAR();

#pragma unroll 1
    for (int L = 0; L < DEPTH; ++L) {
        const bool even = !(L & 1); const int j = L >> 1;
        {
            PHASE_PTRS();
            const int N = even ? NIN_E : NIN_O;
            pg8::Gemm g{XB, (const pg8::bf16_t*)(ws + WS_WIN), M, N, D}; pg8::StaticOrder S; S.init(M, N, F.G, (int)blockIdx.x);
            pg8::EpiIn E{Qb, Kb, Vb, QIb, KIBb, (float*)(ws + WS_WI), (float*)(ws + WS_KISS), (float*)(ws + WS_KM), SS + (size_t)M * 4, even ? 1 : 0};
            pg8::gemm_phase<pg8::EpiIn, pg8::StaticOrder, true, true>(F.lds + RING_OFF, g, S, E, F.wave);
        }
        GRID_BAR();
        RELAUNDER(F);
        if (even) { simple_indexer(F, j); RELAUNDER(F); simple_moba(F, args, j); GRID_BAR(); RELAUNDER(F); simple_dsa(F, args); }
        else simple_dilated(F, args);
        GRID_BAR();
        {
            PHASE_PTRS();
            pg8::Gemm g{Qb, (const pg8::bf16_t*)(ws + WS_WO), M, D, D}; pg8::StaticOrder S; S.init(M, D, F.G, (int)blockIdx.x);
            pg8::EpiRes E{L == 0 ? args.in[0] : (const float*)F.out, F.out, XB, SS, (PG8_LAS float*)(F.lds + AUX_OFF)};
            pg8::gemm_phase<pg8::EpiRes, pg8::StaticOrder, true, true>(F.lds + RING_OFF, g, S, E, F.wave);
        }
        GRID_BAR();
        {
            PHASE_PTRS();
            pg8::Gemm g{XB, (const pg8::bf16_t*)(ws + WS_WUP), M, NUP, D}; pg8::StaticOrder S; S.init(M, NUP, F.G, (int)blockIdx.x);
            pg8::EpiUp E{Gb, (float*)(ws + WS_UE), SS, args.in[9] + (size_t)L * 3 * NUP, args.in[10] + (size_t)L * NUP, (PG8_LAS float*)(F.lds + AUX_OFF)};
            pg8::gemm_phase<pg8::EpiUp, pg8::StaticOrder, true, true>(F.lds + RING_OFF, g, S, E, F.wave);
        }
        GRID_BAR();
        {
            PHASE_PTRS();
            pg8::StaticOrder S; S.init(M, D, F.G, (int)blockIdx.x);
            { pg8::Unit u; for (int i = 0; S.next(i, u); ++i) if (u.pm & 15) fix_rows(F, args, u.pm, L); }
            VM_WAIT(); __syncthreads(); __builtin_amdgcn_fence(__ATOMIC_ACQUIRE, "agent"); VM_WAIT(); __syncthreads();
            pg8::Gemm g{Gb, (const pg8::bf16_t*)(ws + WS_WDN) + (size_t)(L & 1) * D * FF, M, D, FF};
            pg8::EpiRes E{(const float*)F.out, F.out, XB, SS + (size_t)M * 4, (PG8_LAS float*)(F.lds + AUX_OFF)};
            pg8::gemm_phase<pg8::EpiRes, pg8::StaticOrder, true, true>(F.lds + RING_OFF, g, S, E, F.wave);
        }
        RELAUNDER(F);
        if (L + 1 < DEPTH) convert_layer(F, args, L + 1);
        GRID_BAR();
    }
    RELAUNDER(F);
    final_norm(F, args);
#undef GRID_BAR
#undef PHASE_PTRS
}

extern "C" void kernel_launch(void* const* d_in, const int* in_sizes, int n_in, void* d_out, int out_size, void* d_ws, size_t ws_size, hipStream_t stream) {
    static int grid = 0;
    if (grid == 0) {
        if (n_in != 13 || in_sizes[0] != M * D || out_size != M * D || ws_size < WS_END) { fprintf(stderr, "kernel_launch: unexpected problem (n_in %d, in0 %d, out %d, ws %zu)\n", n_in, n_in > 0 ? in_sizes[0] : -1, out_size, ws_size); grid = -1; return; }
        int dev = 0, cus = 0, per_cu = 0;
        if (hipGetDevice(&dev) != hipSuccess || hipDeviceGetAttribute(&cus, hipDeviceAttributeMultiprocessorCount, dev) != hipSuccess) { grid = -1; return; }
        if (hipFuncSetAttribute((const void*)mk_fwd, hipFuncAttributeMaxDynamicSharedMemorySize, LDS_BYTES) != hipSuccess) { fprintf(stderr, "kernel_launch: hipFuncSetAttribute failed\n"); grid = -1; return; }
        if (hipOccupancyMaxActiveBlocksPerMultiprocessor(&per_cu, (const void*)mk_fwd, NWAVES * 64, LDS_BYTES) != hipSuccess || per_cu < 1) { fprintf(stderr, "kernel_launch: occupancy query says %d blocks per CU\n", per_cu); grid = -1; (void)hipGetLastError(); return; }
        grid = cus;
    }
    if (grid < 0) return;
    if (hipMemsetAsync((char*)d_ws + WS_BAR, 0, BAR_ZERO_BYTES, stream) != hipSuccess) return;
    Args a{};
    for (int i = 0; i < 13; ++i) a.in[i] = (const float*)d_in[i];
    a.out = (float*)d_out; a.ws = (unsigned char*)d_ws;
    hipLaunchKernelGGL(mk_fwd, dim3(grid), dim3(NWAVES * 64), LDS_BYTES, stream, a);
}
```

```cpp
#include <hip/hip_runtime.h>
#include <hip/hip_bf16.h>
#include <cstdio>
#include <cstdint>
#include <cmath>

constexpr int BATCH = 4, SEQ = 4096, M = BATCH * SEQ, D = 1024, NH = 16, HD = 64, FF = 2816, NUP = 2 * FF, DEPTH = 4;
constexpr int EVEN_IN = 4176, NIN_E = 4352  , NIN_O = 3072;
constexpr float RMS_EPS = 1e-6f;
constexpr float LOG2E = 1.4426950408889634f;
constexpr float C2 = 0.125f * LOG2E;

#ifndef PROBE_DUP
#define PROBE_DUP 0
#endif
#define REP(mask) for (int rep_ = 0; rep_ < ((PROBE_DUP & (mask)) ? 2 : 1); ++rep_)
namespace pg8 {
#define PG8_LAS __attribute__((address_space(3)))
typedef unsigned short bf16_t;
typedef short bf16x8 __attribute__((ext_vector_type(8)));
typedef float f32x4 __attribute__((ext_vector_type(4)));
typedef unsigned u32x4 __attribute__((ext_vector_type(4)));
constexpr int BM = 256, BK = 64, HALF = 128, HTB = HALF * BK * 2  , STAGE_BYTES = 8 * HTB, NXCD = 8, WGM = 8;

__host__ __device__ __forceinline__ int lds_byte(int r, int c) { const int st = (r >> 4) * 2 + (c >> 5), rr = r & 15, cc = c & 31, ob = rr * 64 + cc * 2; return st * 1024 + (ob ^ (((ob >> 9) & 1) << 5)); }
__host__ __device__ __forceinline__ void stage_rc(int b, int& R, int& C) { const int st = b / 1024, sb = b % 1024, swz = sb ^ (((sb >> 9) & 1) << 5); R = (st >> 1) * 16 + swz / 64; C = (st & 1) * 32 + (swz % 64) / 2; }
__host__ __device__ __forceinline__ int perm32(int rho) { const int n = rho >> 4, i = rho & 15; return 8 * (i >> 2) + 4 * n + (i & 3); }

struct Unit { int pm, pn, idx; };
struct Gemm { const bf16_t* A; const bf16_t* Bt; int M, N, K; };

struct StaticOrder {
    int nM, nN, nwg, G, c;
    __host__ __device__ __forceinline__ void init(int M, int N, int G_, int c_) { nM = M / BM; nN = N / BM; nwg = nM * nN; G = G_; c = c_; }
    __host__ __device__ __forceinline__ bool next(int i, Unit& u) const {
        const long L = (long)i * G + c; if (L >= nwg) return false;
        int wgid = (int)L; { const int q = nwg / NXCD, r = nwg % NXCD, xcd = wgid % NXCD, off = wgid / NXCD; wgid = (xcd < r ? xcd * (q + 1) : r * (q + 1) + (xcd - r) * q) + off; }
        const int nig = WGM * nN, gid = wgid / nig, fm = gid * WGM, gsz = (nM - fm) < WGM ? (nM - fm) : WGM;
        u.pm = fm + ((wgid % nig) % gsz); u.pn = (wgid % nig) / gsz; u.idx = i; return true;
    }
    __device__ __forceinline__ void a_ready(const Unit&) const {}
    __device__ __forceinline__ void done(const Unit&) const {}
};

__device__ __forceinline__ unsigned cvt_pk_bf16(float lo, float hi) { unsigned r; asm volatile("v_cvt_pk_bf16_f32 %0, %1, %2" : "=v"(r) : "v"(lo), "v"(hi)); return r; }
typedef float f32x2 __attribute__((ext_vector_type(2)));
template <int CTRL> __device__ __forceinline__ float dpp_mov(float old, float src) {
    return __builtin_bit_cast(float, __builtin_amdgcn_update_dpp(__builtin_bit_cast(int, old), __builtin_bit_cast(int, src), CTRL, 0xF, 0xF, false));
}
__device__ __forceinline__ float shift1(float x, float y) { return dpp_mov<0x111>(dpp_mov<0x121>(0.f, y), x); }
__device__ __forceinline__ float shift2(float x, float y) { return dpp_mov<0x112>(dpp_mov<0x122>(0.f, y), x); }
__device__ __forceinline__ float dot4(const f32x4 a) { return (a[0] * a[0] + a[1] * a[1]) + (a[2] * a[2] + a[3] * a[3]); }
__device__ __forceinline__ float row_rstd(const float* SSP, int row) {
    const f32x4 a = *(const __attribute__((address_space(1))) f32x4*)(SSP + (size_t)row * 4);
    return __builtin_amdgcn_rsqf(((a[0] + a[1]) + (a[2] + a[3])) * (1.0f / 1024.0f) + 1e-6f);
}

__device__ __forceinline__ void st16_wt(const void* p, u32x4 v) { asm volatile("global_store_dwordx4 %0, %1, off sc0 sc1\n\ts_nop 1" :: "v"(p), "v"(v) : "memory");   }
struct PreRstd { f32x4 a[6]; int n; };
struct PreNone {};
template <class Sched> __device__ __forceinline__ void rstd_pre_issue(PreRstd& P, const Sched& S, const float* ssin, int tid) {
    Unit u; P.n = 0;
#pragma unroll
    for (int i = 0; i < 6; ++i) { P.a[i] = (f32x4){1.f, 1.f, 1.f, 1.f}; if (S.next(i, u)) { P.n = i + 1; if (tid < 256) P.a[i] = *(const __attribute__((address_space(1))) f32x4*)(ssin + (size_t)(u.pm * 256 + tid) * 4); } }
}
__device__ __forceinline__ void rstd_pre_fill(const PreRstd& P, const PG8_LAS float* rtab, int tid) {
    if (tid < 256) {
#pragma unroll
        for (int i = 0; i < 6; ++i) if (i < P.n) ((PG8_LAS float*)rtab)[i * 256 + tid] = __builtin_amdgcn_rsqf(((P.a[i][0] + P.a[i][1]) + (P.a[i][2] + P.a[i][3])) * (1.0f / 1024.0f) + 1e-6f); }
}
template <bool DRY> struct EpiInT {
    static constexpr bool PERM = true, AFTER_DRAIN = false, AROWS8 = false;
    bf16_t *Q, *K, *V, *QI, *KIB; float *WI, *KM; const PG8_LAS float* rtab; int even; PG8_LAS float* ex; const float* ssin;
    typedef PreRstd Pre;
    template <class Sched> __device__ __forceinline__ void pre_issue(Pre& P, const Sched& S, int tid) const { rstd_pre_issue(P, S, ssin, tid); }
    __device__ __forceinline__ void pre_fill(const Pre& P, int tid) const { rstd_pre_fill(P, rtab, tid); }
    __device__ __forceinline__ void operator()(const f32x4 (&acc)[2][2][4][2], const Unit& u, int wr, int wc, int fr_, int fq_) const {
        int fr = fr_, fq = fq_; asm volatile("" : "+v"(fr), "+v"(fq));
        if (DRY) {
#pragma unroll
            for (int ai = 0; ai < 2; ++ai)
#pragma unroll
                for (int bj = 0; bj < 2; ++bj)
#pragma unroll
                    for (int m = 0; m < 4; ++m) asm volatile("" :: "v"(acc[ai][bj][m][0]), "v"(acc[ai][bj][m][1]));
            return; }
        const int row0 = u.pm * BM + wr * 64 + fr;
        float rs[2][4];
#pragma unroll
        for (int ai = 0; ai < 2; ++ai)
#pragma unroll
            for (int m = 0; m < 4; ++m) rs[ai][m] = rtab[u.idx * 256 + ai * HALF + wr * 64 + m * 16 + fr];
        if (u.pn < 16) {
            const int t = u.pn >> 2, colt = (u.pn & 3) * BM;
            bf16_t* base = t == 0 ? Q : (t == 1 ? K : (t == 2 ? V : QI));
            const float sc = t == 0 ? C2 : 1.f;
            const int col0 = colt + wc * 32 + 8 * fq;
#pragma unroll
            for (int ai = 0; ai < 2; ++ai)
#pragma unroll
                for (int m = 0; m < 4; ++m) { const float s = rs[ai][m] * sc; bf16_t* rowp = base + (size_t)(row0 + ai * HALF + m * 16) * 1024 + col0;
#pragma unroll
                    for (int bj = 0; bj < 2; ++bj) { const f32x4 v0 = acc[ai][bj][m][0] * s, v1 = acc[ai][bj][m][1] * s;
                        u32x4 w; w.x = cvt_pk_bf16(v0[0], v0[1]); w.y = cvt_pk_bf16(v0[2], v0[3]); w.z = cvt_pk_bf16(v1[0], v1[1]); w.w = cvt_pk_bf16(v1[2], v1[3]);
                        st16_wt(rowp + bj * HALF, w); } }
            if (even && t == 1 && (u.pn & 3) < 2) {
#pragma unroll
                for (int bj = 0; bj < 2; ++bj)
#pragma unroll
                    for (int n = 0; n < 2; ++n) { f32x4 s = {0.f, 0.f, 0.f, 0.f};
#pragma unroll
                        for (int ai = 0; ai < 2; ++ai)
#pragma unroll
                            for (int m = 0; m < 4; ++m) s += acc[ai][bj][m][n] * rs[ai][m];
#pragma unroll
                        for (int o = 1; o < 16; o <<= 1) { s[0] += __shfl_xor(s[0], o); s[1] += __shfl_xor(s[1], o); s[2] += __shfl_xor(s[2], o); s[3] += __shfl_xor(s[3], o); }
                        if (fr == 0) { const int col = colt + bj * HALF + wc * 32 + 8 * fq + 4 * n, h = col >> 6, d = col & 63;
                            *(__attribute__((address_space(1))) f32x4*)(KM + (((size_t)(((u.pm >> 4) * 8 + h) * 16 + (u.pm & 15))) * 2 + wr) * 64 + d) = s; } }
            }
        } else {
            if (wc < 2) {
#pragma unroll
                for (int ai = 0; ai < 2; ++ai)
#pragma unroll
                    for (int m = 0; m < 4; ++m) { const float s = rs[ai][m];
                        const f32x4 v0 = acc[ai][0][m][0] * s, v1 = acc[ai][0][m][1] * s;
                        float q = dot4(v0) + dot4(v1); q += __shfl_xor(q, 16); q += __shfl_xor(q, 32);
                        if (fq == 0) ex[(ai * HALF + wr * 64 + m * 16 + fr) * 2 + wc] = q; }
            }
            asm volatile("s_waitcnt lgkmcnt(0)" ::: "memory"); __builtin_amdgcn_s_barrier(); asm volatile("" ::: "memory");
            if (wc < 2) {
#pragma unroll
                for (int ai = 0; ai < 2; ++ai)
#pragma unroll
                    for (int m = 0; m < 4; ++m) { const int rt = ai * HALF + wr * 64 + m * 16 + fr, row = u.pm * BM + rt;
                        const float s = rs[ai][m] * __builtin_amdgcn_rsqf((ex[rt * 2] + ex[rt * 2 + 1]) * (1.0f / 64.0f) + 1e-6f);
                        const f32x4 v0 = acc[ai][0][m][0] * s, v1 = acc[ai][0][m][1] * s;
                        u32x4 w; w.x = cvt_pk_bf16(v0[0], v0[1]); w.y = cvt_pk_bf16(v0[2], v0[3]); w.z = cvt_pk_bf16(v1[0], v1[1]); w.w = cvt_pk_bf16(v1[2], v1[3]);
                        *(__attribute__((address_space(1))) u32x4*)(KIB + (size_t)(row >> 5) * 2048 + (wc * 2 + (fq >> 1)) * 512 + (fq & 1) * 256 + (row & 31) * 8) = w; }
            } else if (wc == 2 && fq < 2) {
#pragma unroll
                for (int ai = 0; ai < 2; ++ai)
#pragma unroll
                    for (int m = 0; m < 4; ++m) { const float s = rs[ai][m]; const int row = row0 + ai * HALF + m * 16;
                        *(__attribute__((address_space(1))) f32x4*)(WI + (size_t)row * 16 + 8 * fq) = acc[ai][0][m][0] * s; *(__attribute__((address_space(1))) f32x4*)(WI + (size_t)row * 16 + 8 * fq + 4) = acc[ai][0][m][1] * s; }
            }
        }
    }
};

struct EpiRes {
    static constexpr bool PERM = true, AFTER_DRAIN = false, AROWS8 = false;
    bf16_t* XB; float* SSo; PG8_LAS float* ex;
    typedef PreNone Pre;
    template <class Sched> __device__ __forceinline__ void pre_issue(Pre&, const Sched&, int) const {}
    __device__ __forceinline__ void pre_fill(const Pre&, int) const {}
    __device__ __forceinline__ void operator()(const f32x4 (&acc)[2][2][4][2], const Unit& u, int wr, int wc, int fr_, int fq_) const {
        int fr = fr_, fq = fq_; asm volatile("" : "+v"(fr), "+v"(fq));
        const int row0 = u.pm * BM + wr * 64 + fr, col0 = u.pn * BM + wc * 32 + 8 * fq;
#pragma unroll
        for (int ai = 0; ai < 2; ++ai)
#pragma unroll
            for (int m = 0; m < 4; ++m) { const int row = row0 + ai * HALF + m * 16; const size_t off = (size_t)row * 1024 + col0; float q = 0.f;
#pragma unroll
                for (int bj = 0; bj < 2; ++bj) { const u32x4 b = *(const __attribute__((address_space(1))) u32x4*)(XB + off + bj * HALF);
                    const f32x4 b0 = {__uint_as_float(b.x << 16), __uint_as_float(b.x & 0xffff0000u), __uint_as_float(b.y << 16), __uint_as_float(b.y & 0xffff0000u)};
                    const f32x4 b1 = {__uint_as_float(b.z << 16), __uint_as_float(b.z & 0xffff0000u), __uint_as_float(b.w << 16), __uint_as_float(b.w & 0xffff0000u)};
                    const f32x4 x0 = b0 + acc[ai][bj][m][0], x1 = b1 + acc[ai][bj][m][1];
                    u32x4 w; w.x = cvt_pk_bf16(x0[0], x0[1]); w.y = cvt_pk_bf16(x0[2], x0[3]); w.z = cvt_pk_bf16(x1[0], x1[1]); w.w = cvt_pk_bf16(x1[2], x1[3]);
                    st16_wt(XB + off + bj * HALF, w); q += dot4(x0) + dot4(x1); }
                q += __shfl_xor(q, 16); q += __shfl_xor(q, 32);
                if (fq == 0) ex[(ai * HALF + wr * 64 + m * 16 + fr) * 4 + wc] = q; }
        asm volatile("s_waitcnt lgkmcnt(0)" ::: "memory"); __builtin_amdgcn_s_barrier(); asm volatile("" ::: "memory");
        const int t = (wr * 4 + wc) * 64 + fq * 16 + fr;
        if (t < 256) { const f32x4 p = *(const PG8_LAS f32x4*)(ex + t * 4); ((__attribute__((address_space(1))) float*)SSo)[(size_t)(u.pm * BM + t) * 4 + u.pn] = (p[0] + p[1]) + (p[2] + p[3]); }
    }
};

typedef float f32x2 __attribute__((ext_vector_type(2)));
template <bool DRY> struct EpiUpT {
    static constexpr bool PERM = true, AFTER_DRAIN = false, AROWS8 = true;
    bf16_t* G; float* UE; const PG8_LAS float* rtab; const float* cw; const float* cb; PG8_LAS float* ex; const float* ssin;
    typedef PreRstd Pre;
    template <class Sched> __device__ __forceinline__ void pre_issue(Pre& P, const Sched& S, int tid) const { rstd_pre_issue(P, S, ssin, tid); }
    __device__ __forceinline__ void pre_fill(const Pre& P, int tid) const { rstd_pre_fill(P, rtab, tid); }
    __device__ __forceinline__ void operator()(f32x4 (&acc)[2][2][4][2], const Unit& u, int wr, int wc, int fr_, int fq_) const {
        int fr = fr_, fq = fq_; asm volatile("" : "+v"(fr), "+v"(fq));
        if (DRY) {
#pragma unroll
            for (int ai = 0; ai < 2; ++ai)
#pragma unroll
                for (int bj = 0; bj < 2; ++bj)
#pragma unroll
                    for (int m = 0; m < 4; ++m) asm volatile("" :: "v"(acc[ai][bj][m][0]), "v"(acc[ai][bj][m][1]));
            return; }
        const int rowb = u.pm * BM + (wr * 16 + fr) * 8;
#pragma unroll
        for (int ai = 0; ai < 2; ++ai)
#pragma unroll
            for (int m = 0; m < 4; ++m) { const float s = rtab[u.idx * 256 + (wr * 16 + fr) * 8 + 4 * ai + m];
#pragma unroll
                for (int bj = 0; bj < 2; ++bj)
#pragma unroll
                    for (int n = 0; n < 2; ++n) acc[ai][bj][m][n] *= s; }
        const int cidx = wc * 32 + 8 * fq;
        if (wr == 0 && fr == 15) {
#pragma unroll
            for (int k = 0; k < 2; ++k)
#pragma unroll
                for (int bj = 0; bj < 2; ++bj)
#pragma unroll
                    for (int n = 0; n < 2; ++n) *(PG8_LAS f32x4*)(ex + k * 256 + bj * 128 + cidx + 4 * n) = acc[1][bj][2 + k][n];
        }
        float* ue = UE + (size_t)u.pm * 4 * NUP + u.pn * 256 + cidx;
        if (wr == 0 && fr == 0) {
#pragma unroll
            for (int k = 0; k < 2; ++k)
#pragma unroll
                for (int bj = 0; bj < 2; ++bj)
#pragma unroll
                    for (int n = 0; n < 2; ++n) *(__attribute__((address_space(1))) f32x4*)(ue + (size_t)k * NUP + bj * 128 + 4 * n) = acc[0][bj][k][n];
        }
        if (wr == 1 && fr == 15) {
#pragma unroll
            for (int k = 0; k < 2; ++k)
#pragma unroll
                for (int bj = 0; bj < 2; ++bj)
#pragma unroll
                    for (int n = 0; n < 2; ++n) *(__attribute__((address_space(1))) f32x4*)(ue + (size_t)(2 + k) * NUP + bj * 128 + 4 * n) = acc[1][bj][2 + k][n];
        }
        const int ffc = u.pn * 128 + cidx;
        f32x4 cwv[8]; unsigned hold[8][2];
#define EPIUP_LOADW(c_) do { cwv[0] = *(const __attribute__((address_space(1))) f32x4*)(cw + (c_)); cwv[1] = *(const __attribute__((address_space(1))) f32x4*)(cw + NUP + (c_)); cwv[2] = *(const __attribute__((address_space(1))) f32x4*)(cw + 2 * NUP + (c_)); cwv[3] = *(const __attribute__((address_space(1))) f32x4*)(cb + (c_)); \
            cwv[4] = *(const __attribute__((address_space(1))) f32x4*)(cw + FF + (c_)); cwv[5] = *(const __attribute__((address_space(1))) f32x4*)(cw + NUP + FF + (c_)); cwv[6] = *(const __attribute__((address_space(1))) f32x4*)(cw + 2 * NUP + FF + (c_)); cwv[7] = *(const __attribute__((address_space(1))) f32x4*)(cb + FF + (c_)); } while (0)
        EPIUP_LOADW(ffc);
        asm volatile("s_waitcnt lgkmcnt(0)" ::: "memory"); __builtin_amdgcn_s_barrier(); asm volatile("" ::: "memory");
        f32x4 cwn[8];
        { const int c_ = ffc + 4;
          cwn[0] = *(const __attribute__((address_space(1))) f32x4*)(cw + c_); cwn[1] = *(const __attribute__((address_space(1))) f32x4*)(cw + NUP + c_); cwn[2] = *(const __attribute__((address_space(1))) f32x4*)(cw + 2 * NUP + c_); cwn[3] = *(const __attribute__((address_space(1))) f32x4*)(cb + c_);
          cwn[4] = *(const __attribute__((address_space(1))) f32x4*)(cw + FF + c_); cwn[5] = *(const __attribute__((address_space(1))) f32x4*)(cw + NUP + FF + c_); cwn[6] = *(const __attribute__((address_space(1))) f32x4*)(cw + 2 * NUP + FF + c_); cwn[7] = *(const __attribute__((address_space(1))) f32x4*)(cb + FF + c_); }
#pragma unroll
        for (int n = 0; n < 2; ++n) {
            if (n == 1) {
#pragma unroll
                for (int q_ = 0; q_ < 8; ++q_) cwv[q_] = cwn[q_]; }
            const f32x4 w0v = cwv[0], w1v = cwv[1], w2v = cwv[2], bv = cwv[3], w0g = cwv[4], w1g = cwv[5], w2g = cwv[6], bg = cwv[7];
            f32x4 e6v = {0.f, 0.f, 0.f, 0.f}, e7v = e6v, e6g = e6v, e7g = e6v;
            if (wr == 1 && fr == 0) { const PG8_LAS float* e = ex + cidx + 4 * n; e6v = *(const PG8_LAS f32x4*)e; e6g = *(const PG8_LAS f32x4*)(e + 128); e7v = *(const PG8_LAS f32x4*)(e + 256); e7g = *(const PG8_LAS f32x4*)(e + 256 + 128); }
            f32x4 p2v, p1v, p2g, p1g;
#pragma unroll
            for (int j = 0; j < 4; ++j) { p2v[j] = dpp_mov<0x111>(e6v[j], acc[1][0][2][n][j]); p1v[j] = dpp_mov<0x111>(e7v[j], acc[1][0][3][n][j]);
                                          p2g[j] = dpp_mov<0x111>(e6g[j], acc[1][1][2][n][j]); p1g[j] = dpp_mov<0x111>(e7g[j], acc[1][1][3][n][j]); }
#define EPIUP_LO(v_) __builtin_shufflevector(v_, v_, 0, 1)
#define EPIUP_HI(v_) __builtin_shufflevector(v_, v_, 2, 3)
#pragma unroll
            for (int k = 0; k < 8; ++k) {
                const f32x4 uv = acc[k >> 2][0][k & 3][n], ug = acc[k >> 2][1][k & 3][n];
                f32x2 g2[2];
#pragma unroll
                for (int h = 0; h < 2; ++h) {
                    const f32x2 cv = __builtin_elementwise_fma(h ? EPIUP_HI(w2v) : EPIUP_LO(w2v), h ? EPIUP_HI(uv) : EPIUP_LO(uv), __builtin_elementwise_fma(h ? EPIUP_HI(w1v) : EPIUP_LO(w1v), h ? EPIUP_HI(p1v) : EPIUP_LO(p1v),
                                     __builtin_elementwise_fma(h ? EPIUP_HI(w0v) : EPIUP_LO(w0v), h ? EPIUP_HI(p2v) : EPIUP_LO(p2v), h ? EPIUP_HI(bv) : EPIUP_LO(bv))));
                    const f32x2 cg = __builtin_elementwise_fma(h ? EPIUP_HI(w2g) : EPIUP_LO(w2g), h ? EPIUP_HI(ug) : EPIUP_LO(ug), __builtin_elementwise_fma(h ? EPIUP_HI(w1g) : EPIUP_LO(w1g), h ? EPIUP_HI(p1g) : EPIUP_LO(p1g),
                                     __builtin_elementwise_fma(h ? EPIUP_HI(w0g) : EPIUP_LO(w0g), h ? EPIUP_HI(p2g) : EPIUP_LO(p2g), h ? EPIUP_HI(bg) : EPIUP_LO(bg))));
                    const f32x2 den = (f32x2){__builtin_amdgcn_exp2f(cg.x), __builtin_amdgcn_exp2f(cg.y)} + (f32x2){1.0f, 1.0f};
                    g2[h] = (cv * cg) * (f32x2){__builtin_amdgcn_rcpf(den.x), __builtin_amdgcn_rcpf(den.y)};
                }
                if (n == 0) { hold[k][0] = cvt_pk_bf16(g2[0].x, g2[0].y); hold[k][1] = cvt_pk_bf16(g2[1].x, g2[1].y); }
                else { u32x4 w; w.x = hold[k][0]; w.y = hold[k][1]; w.z = cvt_pk_bf16(g2[0].x, g2[0].y); w.w = cvt_pk_bf16(g2[1].x, g2[1].y);
                       st16_wt(G + (size_t)(rowb + k) * FF + ffc, w); }
                p2v = p1v; p1v = uv; p2g = p1g; p1g = ug;
            }
        }
    }
};
#undef EPIUP_LOADW
#undef EPIUP_LO
#undef EPIUP_HI
typedef EpiInT<false> EpiIn; typedef EpiUpT<false> EpiUp;
template <class Epi, class Sched, bool ALIGN_EPI = false, bool SP2 = false>
__device__ __forceinline__ void gemm_phase(PG8_LAS unsigned char* lds, const Gemm g, const Sched& S, const Epi& E, const int wave_sgpr) {
    int tid_; asm volatile("v_mbcnt_lo_u32_b32 %0, -1, 0\n\tv_mbcnt_hi_u32_b32 %0, -1, %0" : "=v"(tid_)); tid_ += wave_sgpr * 64;
    const int tid = tid_, wid = __builtin_amdgcn_readfirstlane(tid >> 6), lane = tid & 63, wr = wid >> 2, wc = wid & 3, fr = lane & 15, fq = lane >> 4;
    const int K = g.K, nt = K / BK;
    unsigned voffA[2], voffB[2];
#pragma unroll
    for (int i = 0; i < 2; ++i) { int R, C; stage_rc(tid * 16 + i * 8192, R, C); const int Rb = Epi::PERM ? ((R & ~31) + perm32(R & 31)) : R;
        const int Ra = Epi::AROWS8 ? (((R >> 6) * 16 + (R & 15)) * 8 + ((R >> 4) & 3)) : R;
        voffA[i] = (unsigned)(Ra * K + C) * 2u; voffB[i] = (unsigned)(Rb * K + C) * 2u; }
    const size_t kstep = (size_t)(BK * 2);
    const size_t hstep = (size_t)HALF * K * 2;
    const size_t tstep = 2 * hstep;
    const size_t hstepA = Epi::AROWS8 ? (size_t)4 * K * 2 : hstep;
    const unsigned ldsw = (unsigned)wid * 1024u;
    const int aoff = lds_byte(wr * 64 + fr, fq * 8), boff = lds_byte(wc * 32 + fr, fq * 8);
#define PG8_SA(b, h) (((b) * 2 + (h)) * HTB)
#define PG8_SB(b, h) ((4 + (b) * 2 + (h)) * HTB)
#define PG8_STAGE(bufoff, gbase, voff) do { _Pragma("unroll") for (int _i = 0; _i < 2; ++_i) \
        __builtin_amdgcn_global_load_lds((const unsigned*)((const char*)(gbase) + (voff)[_i]), (PG8_LAS unsigned*)(lds + (bufoff) + ldsw + _i * 8192), 16, 0, 0); } while (0)
#define PG8_LDA(dst, b, h) do { _Pragma("unroll") for (int m = 0; m < 4; ++m) _Pragma("unroll") for (int k = 0; k < 2; ++k) dst[m][k] = *(const PG8_LAS bf16x8*)(lds + PG8_SA(b, h) + aoff + m * 2048 + k * 1024); } while (0)
#define PG8_LDB(dst, b, h) do { _Pragma("unroll") for (int n = 0; n < 2; ++n) _Pragma("unroll") for (int k = 0; k < 2; ++k) dst[n][k] = *(const PG8_LAS bf16x8*)(lds + PG8_SB(b, h) + boff + n * 2048 + k * 1024); } while (0)
#define PG8_MMA(ai, bj, At, Bt) do { __builtin_amdgcn_s_setprio(1); _Pragma("unroll") for (int m = 0; m < 4; ++m) _Pragma("unroll") for (int n = 0; n < 2; ++n) _Pragma("unroll") for (int k = 0; k < 2; ++k) \
        acc[ai][bj][m][n] = __builtin_amdgcn_mfma_f32_16x16x32_bf16(Bt[n][k], At[m][k], acc[ai][bj][m][n], 0, 0, 0); __builtin_amdgcn_s_setprio(0); } while (0)
#define PG8_WAIT_V(n) asm volatile("s_waitcnt vmcnt(" #n ")" ::: "memory")
#define PG8_WAIT_L(n) asm volatile("s_waitcnt lgkmcnt(" #n ")" ::: "memory")
#define PG8_BAR __builtin_amdgcn_s_barrier()
#define PG8_SCHED __builtin_amdgcn_sched_barrier(0)
    Unit cur, nxt; int ui = 0;
    if (!S.next(0, cur)) return;
    f32x4 acc[2][2][4][2];
#pragma unroll
    for (int a = 0; a < 2; ++a)
#pragma unroll
        for (int b = 0; b < 2; ++b)
#pragma unroll
            for (int m = 0; m < 4; ++m)
#pragma unroll
                for (int n = 0; n < 2; ++n) acc[a][b][m][n] = (f32x4){0.f, 0.f, 0.f, 0.f};
    bf16x8 At[4][2], B0[2][2], B1[2][2];
    const char* cA = (const char*)g.A + (size_t)cur.pm * tstep; const char* cB = (const char*)g.Bt + (size_t)cur.pn * tstep;
    S.a_ready(cur);
    typename Epi::Pre pre_; E.pre_issue(pre_, S, tid);
    if constexpr (SP2) {
        PG8_STAGE(PG8_SB(0, 0), cB, voffB); PG8_STAGE(PG8_SB(0, 1), cB + hstep, voffB); PG8_STAGE(PG8_SA(0, 0), cA, voffA); PG8_STAGE(PG8_SA(0, 1), cA + hstepA, voffA);
        E.pre_fill(pre_, tid);
        if (wr == 1) PG8_BAR;
        PG8_WAIT_V(2); PG8_BAR;
        PG8_STAGE(PG8_SB(1, 0), cB + kstep, voffB); PG8_STAGE(PG8_SA(1, 0), cA + kstep, voffA); PG8_STAGE(PG8_SB(1, 1), cB + hstep + kstep, voffB);
        PG8_WAIT_V(6); PG8_BAR;
    } else {
        PG8_STAGE(PG8_SB(0, 0), cB, voffB); PG8_STAGE(PG8_SA(0, 0), cA, voffA); PG8_STAGE(PG8_SB(0, 1), cB + hstep, voffB); PG8_STAGE(PG8_SA(0, 1), cA + hstepA, voffA);
        if (wr == 1) PG8_BAR;
        PG8_WAIT_V(4); PG8_BAR;
        PG8_STAGE(PG8_SB(1, 0), cB + kstep, voffB); PG8_STAGE(PG8_SA(1, 0), cA + kstep, voffA); PG8_STAGE(PG8_SB(1, 1), cB + hstep + kstep, voffB);
        PG8_WAIT_V(6); PG8_BAR;
    }
    for (;;) {
        const bool has_next = S.next(ui + 1, nxt);
        const char* nA = has_next ? (const char*)g.A + (size_t)nxt.pm * tstep : cA; const char* nB = has_next ? (const char*)g.Bt + (size_t)nxt.pn * tstep : cB;
        for (int t = 0; t < nt; t += 2) {
            const bool last = (t == nt - 2);
            const char* a1 = cA + (size_t)(t + 1) * kstep;
            const char* a2 = last ? nA : cA + (size_t)(t + 2) * kstep; const char* b2 = last ? nB : cB + (size_t)(t + 2) * kstep;
            const char* a3 = a2 + kstep; const char* b3 = b2 + kstep;
            if (last && has_next) S.a_ready(nxt);
            if constexpr (SP2) {
            PG8_LDB(B0, 0, 0); PG8_LDB(B1, 0, 1); PG8_SCHED; PG8_LDA(At, 0, 0); PG8_STAGE(PG8_SA(1, 1), a1 + hstepA, voffA);
            PG8_WAIT_V(8); PG8_WAIT_L(0); PG8_BAR; PG8_MMA(0, 0, At, B0); PG8_MMA(0, 1, At, B1); PG8_BAR; PG8_SCHED;
            PG8_LDA(At, 0, 1); PG8_STAGE(PG8_SB(0, 0), b2, voffB); PG8_STAGE(PG8_SB(0, 1), b2 + hstep, voffB); PG8_STAGE(PG8_SA(0, 0), a2, voffA);
            PG8_WAIT_V(8); PG8_WAIT_L(0); PG8_BAR; PG8_MMA(1, 0, At, B0); PG8_MMA(1, 1, At, B1); PG8_BAR; PG8_SCHED;
            PG8_LDB(B0, 1, 0); PG8_LDB(B1, 1, 1); PG8_SCHED; PG8_LDA(At, 1, 0); PG8_STAGE(PG8_SA(0, 1), a2 + hstepA, voffA);
            PG8_WAIT_V(8); PG8_WAIT_L(0); PG8_BAR; PG8_MMA(0, 0, At, B0); PG8_MMA(0, 1, At, B1); PG8_BAR; PG8_SCHED;
            PG8_LDA(At, 1, 1); PG8_STAGE(PG8_SB(1, 0), b3, voffB); PG8_STAGE(PG8_SB(1, 1), b3 + hstep, voffB); PG8_STAGE(PG8_SA(1, 0), a3, voffA);
            PG8_WAIT_V(8); PG8_WAIT_L(0); PG8_BAR; PG8_MMA(1, 0, At, B0); PG8_MMA(1, 1, At, B1); PG8_BAR; PG8_SCHED;
            } else {
            PG8_LDB(B0, 0, 0); PG8_SCHED; PG8_LDA(At, 0, 0); PG8_STAGE(PG8_SA(1, 1), a1 + hstepA, voffA);
            PG8_WAIT_L(8); PG8_BAR; PG8_WAIT_L(0); PG8_MMA(0, 0, At, B0); PG8_BAR; PG8_SCHED;
            PG8_LDB(B1, 0, 1); PG8_STAGE(PG8_SB(0, 0), b2, voffB);
            PG8_BAR; PG8_WAIT_L(0); PG8_MMA(0, 1, At, B1); PG8_BAR;
            PG8_LDA(At, 0, 1); PG8_STAGE(PG8_SA(0, 0), a2, voffA);
            PG8_BAR; PG8_WAIT_L(0); PG8_MMA(1, 0, At, B0); PG8_BAR; PG8_SCHED;
            PG8_STAGE(PG8_SB(0, 1), b2 + hstep, voffB);
            PG8_WAIT_V(6); PG8_BAR; PG8_MMA(1, 1, At, B1); PG8_BAR;
            PG8_LDB(B0, 1, 0); PG8_SCHED; PG8_LDA(At, 1, 0); PG8_STAGE(PG8_SA(0, 1), a2 + hstepA, voffA);
            PG8_WAIT_L(8); PG8_BAR; PG8_WAIT_L(0); PG8_MMA(0, 0, At, B0); PG8_BAR; PG8_SCHED;
            PG8_LDB(B1, 1, 1); PG8_STAGE(PG8_SB(1, 0), b3, voffB);
            PG8_BAR; PG8_WAIT_L(0); PG8_MMA(0, 1, At, B1); PG8_BAR;
            PG8_LDA(At, 1, 1); PG8_STAGE(PG8_SA(1, 0), a3, voffA);
            PG8_BAR; PG8_WAIT_L(0); PG8_MMA(1, 0, At, B0); PG8_BAR; PG8_SCHED;
            PG8_STAGE(PG8_SB(1, 1), b3 + hstep, voffB);
            PG8_WAIT_V(6); PG8_BAR; PG8_MMA(1, 1, At, B1); PG8_BAR;
            }
        }
        if constexpr (ALIGN_EPI) { if (wr == 0) PG8_BAR; }
        if constexpr (!Epi::AFTER_DRAIN) { E(acc, cur, wr, wc, fr, fq); S.done(cur); }
        if (!has_next) break;
#pragma unroll
        for (int a = 0; a < 2; ++a)
#pragma unroll
            for (int b = 0; b < 2; ++b)
#pragma unroll
                for (int m = 0; m < 4; ++m)
#pragma unroll
                    for (int n = 0; n < 2; ++n) acc[a][b][m][n] = (f32x4){0.f, 0.f, 0.f, 0.f};
        cur = nxt; cA = nA; cB = nB; ++ui;
        if constexpr (ALIGN_EPI) { if (wr == 1) PG8_BAR; }
    }
    PG8_WAIT_V(0);
    if constexpr (!ALIGN_EPI) { if (wr == 0) PG8_BAR; }
    PG8_BAR;
    if constexpr (Epi::AFTER_DRAIN) { E.fused(acc, cur, wr, wc, fr, fq, lds, wid, lane); S.done(cur); }
#undef PG8_SA
#undef PG8_SB
#undef PG8_STAGE
#undef PG8_LDA
#undef PG8_LDB
#undef PG8_MMA
#undef PG8_WAIT_V
#undef PG8_WAIT_L
#undef PG8_BAR
#undef PG8_SCHED
}
}
#define GAS __attribute__((address_space(1)))
#define LAS __attribute__((address_space(3)))
typedef unsigned short bf16;
typedef unsigned v4u __attribute__((ext_vector_type(4)));
typedef float f32x4 __attribute__((ext_vector_type(4)));
typedef short bf16x8 __attribute__((ext_vector_type(8)));
typedef GAS unsigned gu32;
typedef GAS unsigned long long gu64;
#define RLX_AGENT __ATOMIC_RELAXED, __HIP_MEMORY_SCOPE_AGENT
#define LDS_WAIT() asm volatile("s_waitcnt lgkmcnt(0)" ::: "memory")
#define VM_WAIT() asm volatile("s_waitcnt vmcnt(0)" ::: "memory")
__device__ __forceinline__ unsigned long long rt() { return __builtin_amdgcn_s_memrealtime(); }
__device__ __forceinline__ unsigned f2bf(float f) { unsigned u = __builtin_bit_cast(unsigned, f); return (u + 0x7fffu + ((u >> 16) & 1u)) >> 16; }
__device__ __forceinline__ unsigned pk2(float lo, float hi) { return f2bf(lo) | (f2bf(hi) << 16); }

#define XB_TMO      128
#define XB_XCNT(j)  (256  + 64 * (j))
#define XB_XSUB(j)  (1280 + 64 * (j))
#define XB_XGEN(j)  (2304 + 64 * (j))
#define XB_TOP      3328
#define XB_TOPGEN   3392
#define XCD_BAR_WORDS 3456
#define XB_SPIN_CAP (1u << 18)

__device__ __forceinline__ unsigned xb_ld(unsigned* p)              { return __hip_atomic_load(p, __ATOMIC_RELAXED, __HIP_MEMORY_SCOPE_AGENT); }
__device__ __forceinline__ unsigned xb_add(unsigned* p, unsigned v) { return __hip_atomic_fetch_add(p, v, __ATOMIC_RELAXED, __HIP_MEMORY_SCOPE_AGENT); }
__device__ __forceinline__ unsigned xb_xcc_id() { return (unsigned)__builtin_amdgcn_s_getreg((3 << 11) | 20) & 0xFu; }
#define XB_SPIN(cond, bar) do { unsigned _sp = 0; while (cond) { __builtin_amdgcn_s_sleep(1); \
    if ((++_sp & 255u) == 0u) { if (xb_ld(&(bar)[XB_TMO])) break; if (_sp > XB_SPIN_CAP) { atomicAdd(&(bar)[XB_TMO], 1u); break; } } } } while (0)

__device__ __forceinline__ int hw_lane() { int l; asm volatile("v_mbcnt_lo_u32_b32 %0, -1, 0\n\tv_mbcnt_hi_u32_b32 %0, -1, %0" : "=v"(l)); return l; }
struct XcdBarrier {
    int wave; unsigned* bar; unsigned x;
    volatile LAS unsigned* st;
};

__device__ __forceinline__ XcdBarrier xcd_barrier_post(unsigned* bar, volatile LAS unsigned* st, int wave) {
    XcdBarrier b; b.bar = bar; b.x = xb_xcc_id(); b.st = st; b.wave = wave;
    if (wave == 0 && hw_lane() == 0) (void)xb_add(&bar[XB_XCNT(b.x)], 1u);
    return b;
}
__device__ __forceinline__ void xcd_barrier_complete(unsigned* bar, unsigned x, unsigned& nloc, unsigned& nx) {
    const unsigned G = gridDim.x * gridDim.y * gridDim.z;
    unsigned sum, cnt, mine, sp = 0u;
    for (;;) {
        sum = 0u; cnt = 0u; mine = 0u;
#pragma unroll
        for (unsigned j = 0; j < 16; ++j) { const unsigned c = xb_ld(&bar[XB_XCNT(j)]); sum += c; cnt += (c > 0u) ? 1u : 0u; mine = (j == x) ? c : mine; }
        if (sum == G) break;
        __builtin_amdgcn_s_sleep(1);
        if ((++sp & 255u) == 0u) { if (xb_ld(&bar[XB_TMO])) break; if (sp > XB_SPIN_CAP) { atomicAdd(&bar[XB_TMO], 1u); break; } }
    }
    nloc = mine > 0u ? mine : 1u; nx = cnt > 0u ? cnt : 1u;
}

__device__ __forceinline__ unsigned xb_xcc_id_v() { unsigned r; asm volatile("s_getreg_b32 %0, hwreg(20, 0, 4)" : "=s"(r)); return r & 0xFu; }
__device__ __forceinline__ void xcd_barrier(const XcdBarrier& b_) {
    XcdBarrier b; { unsigned* bp = b_.bar; asm volatile("" : "+s"(bp)); b.bar = bp; } b.st = b_.st; b.wave = b_.wave; b.x = xb_xcc_id_v();
    asm volatile("s_waitcnt vmcnt(0)" ::: "memory");
    __syncthreads();
    if (b.wave == 0 && hw_lane() == 0) {
        unsigned* bar = b.bar;
        __builtin_amdgcn_s_waitcnt(0);
        unsigned nloc = b.st[0], nx = b.st[1];
        if (nloc == 0u) { xcd_barrier_complete(bar, b.x, nloc, nx); b.st[0] = nloc; b.st[1] = nx; }
        const unsigned old = xb_add(&bar[XB_XSUB(b.x)], 1u);
        const unsigned gen = old / nloc;
        if (old + 1u == (gen + 1u) * nloc) {
            __builtin_amdgcn_fence(__ATOMIC_RELEASE, "agent");
            asm volatile("s_waitcnt vmcnt(0)" ::: "memory");
            const unsigned og = xb_add(&bar[XB_TOP], 1u);
            const unsigned tg = og / nx;
            if (og + 1u == (tg + 1u) * nx) xb_add(&bar[XB_TOPGEN], 1u);
            else XB_SPIN(xb_ld(&bar[XB_TOPGEN]) == tg, bar);
            __builtin_amdgcn_fence(__ATOMIC_ACQUIRE, "agent");
            xb_add(&bar[XB_XGEN(b.x)], 1u);
            asm volatile("s_waitcnt vmcnt(0)" ::: "memory");
        } else {
            XB_SPIN(xb_ld(&bar[XB_XGEN(b.x)]) == gen, bar);
            __builtin_amdgcn_fence(__ATOMIC_ACQUIRE, "agent");
            asm volatile("s_waitcnt vmcnt(0)" ::: "memory");
        }
    }
    __syncthreads();
}

constexpr size_t MiB = 1u << 20;
constexpr size_t WS_BAR = 0, BAR_ZERO_BYTES = 65536;
constexpr size_t WS_CW = 512 * 1024;
constexpr size_t WS_SS = 1 * MiB;
constexpr size_t WS_KM = 3 * MiB;
constexpr size_t WS_KISS = 3 * MiB + 512 * 1024;
constexpr size_t WS_WI = 4 * MiB;
constexpr size_t WS_KIB = 5 * MiB;
constexpr size_t WS_UE = 7 * MiB;
constexpr size_t WS_MASK = 13 * MiB;
constexpr size_t WS_WIN = 21 * MiB, WS_WO = 30 * MiB, WS_WUP = 32 * MiB, WS_WDN = 43 * MiB;
constexpr size_t WS_XB = 54 * MiB;
constexpr size_t WS_Q = 86 * MiB, WS_K = 118 * MiB, WS_V = 150 * MiB, WS_QI = 182 * MiB;
constexpr size_t WS_G = 118 * MiB;
constexpr size_t WS_WUP2 = 214 * MiB;
constexpr size_t WS_END = 226 * MiB;
static_assert(WS_G + (size_t)M * FF * 2 <= WS_END && WS_WDN + 2 * (size_t)D * FF * 2 <= WS_XB && WS_WUP + (size_t)NUP * D * 2 <= WS_WDN && WS_WIN + (size_t)NIN_E * D * 2 <= WS_WO, "d_ws map");
static_assert(WS_UE + (size_t)64 * 4 * NUP * 4 <= WS_MASK && WS_MASK + (size_t)M * 64 * 8 <= WS_WIN, "d_ws map 2");

constexpr int RING_OFF = 0, RING_BYTES = 131072;
constexpr int AUX_OFF = 131072, AUX_BYTES = 25600;
constexpr int LDSCTL_OFF = AUX_OFF + AUX_BYTES, MISC_OFF = LDSCTL_OFF + 320;
constexpr int LDS_BYTES = 157184;
static_assert(MISC_OFF + 128 <= LDS_BYTES, "LDS map");
constexpr int NWAVES = 8;

struct Frame {
    LAS unsigned char* lds;
    volatile LAS unsigned* MISC;
    int tid, lane, wave, G, vcu;
    float* out; unsigned char* ws;
};
struct Args { const float* in[13]; float* out; unsigned char* ws; };
#define RELAUNDER(F) do { int l_ = hw_lane(); asm volatile("" : "+v"(l_)); (F).lane = l_; (F).tid = (F).wave * 64 + l_; \
    unsigned char* w_ = args.ws; asm volatile("" : "+s"(w_)); (F).ws = w_; } while (0)

__device__ __forceinline__ float wave_sum(float v) {
#pragma unroll
    for (int o = 1; o < 64; o <<= 1) v += __shfl_xor(v, o);
    return v;
}
__device__ __forceinline__ float wave_max(float v) {
#pragma unroll
    for (int o = 1; o < 64; o <<= 1) v = fmaxf(v, __shfl_xor(v, o));
    return v;
}
__device__ __forceinline__ int t5_bucket(int d) {
    if (d < 16) return d;
    int b = 16;
    b += (d >= 19); b += (d >= 21); b += (d >= 24); b += (d >= 27); b += (d >= 31); b += (d >= 35); b += (d >= 40); b += (d >= 46);
    b += (d >= 52); b += (d >= 59); b += (d >= 67); b += (d >= 77); b += (d >= 87); b += (d >= 99); b += (d >= 113);
    return b;
}

__device__ __forceinline__ void tr_item(const float* W, int ldn, int scol0, int nvalid, int k0, const float* gk, const float* sn, bf16* WT, int Kd, int drow0, LAS float* scr, int lane) {
    const int kq = lane >> 3, n4 = (lane & 7) * 4;
    f32x4 v[8]; float gsc[8];
#pragma unroll
    for (int i = 0; i < 8; ++i) { const int kk = 8 * i + kq;
        v[i] = (n4 < nvalid) ? *(const GAS f32x4*)(W + (size_t)(k0 + kk) * ldn + scol0 + n4) : (f32x4){0.f, 0.f, 0.f, 0.f};
        gsc[i] = gk ? gk[k0 + kk] : 1.f; }
#pragma unroll
    for (int i = 0; i < 8; ++i) { const int kk = 8 * i + kq; const f32x4 t = v[i] * gsc[i]; LAS float* d = scr + kk * 33 + n4; d[0] = t[0]; d[1] = t[1]; d[2] = t[2]; d[3] = t[3]; }
    LDS_WAIT(); asm volatile("" ::: "memory");
    const int c = lane & 7;
#pragma unroll
    for (int j = 0; j < 4; ++j) { const int n = (lane >> 3) + 8 * j; const LAS float* s = scr + (8 * c) * 33 + n; const float f = sn ? sn[(drow0 + n) & 63] : 1.f;
        v4u o; o.x = pk2(s[0 * 33] * f, s[1 * 33] * f); o.y = pk2(s[2 * 33] * f, s[3 * 33] * f); o.z = pk2(s[4 * 33] * f, s[5 * 33] * f); o.w = pk2(s[6 * 33] * f, s[7 * 33] * f);
        *(GAS v4u*)(WT + (size_t)(drow0 + n) * Kd + k0 + 8 * c) = o; }
    LDS_WAIT(); asm volatile("" ::: "memory");
}
__device__ __forceinline__ void convert_layer(Frame& F, const Args& A, int L, int gw, int NGW, const int which = 15) {
    LAS float* scr = (LAS float*)(F.lds + RING_OFF + F.wave * 16384);
    const int j = L >> 1; const bool even = !(L & 1);
    const int nb_in = even ? NIN_E / 32 : NIN_O / 32;
    const int I_IN = 16 * nb_in, I_O = 16 * 32, I_UP = 16 * (NUP / 32), I_DN = (FF / 64) * (D / 32);
    const int NIT = I_IN + I_O + I_UP + I_DN;
    bf16* WinT = (bf16*)(F.ws + WS_WIN); bf16* WoT = (bf16*)(F.ws + WS_WO); bf16* WupT = (bf16*)(F.ws + ((L & 1) ? WS_WUP2 : WS_WUP)); bf16* WdnT = (bf16*)(F.ws + WS_WDN) + (size_t)(L & 1) * D * FF;
    for (int it = gw; it < NIT; it += NGW) {
        int r = it;
        if (r < I_IN) {
            if (!(which & 1)) continue;
            const int kb = r / nb_in, nb = r % nb_in, dr = 32 * nb;
            if (even) {
                int sc0, nv = 32; const float* sn = nullptr;
                if (dr < 512) sc0 = dr; else if (dr < 1024) sc0 = 1536 + (dr - 512); else if (dr < 1536) sc0 = 512 + (dr - 1024); else if (dr < 2048) sc0 = 2048 + (dr - 1536);
                else if (dr < 2560) sc0 = 1024 + (dr - 2048); else if (dr < 3072) sc0 = 2560 + (dr - 2560); else if (dr < 4096) { sc0 = dr; sn = A.in[2] + j * 64; }
                else if (dr < 4160) sc0 = dr; else if (dr == 4160) { sc0 = 4160; nv = 16; } else { sc0 = 0; nv = 0; }
                tr_item(A.in[1] + (size_t)j * D * EVEN_IN, EVEN_IN, sc0, nv, 64 * kb, A.in[6] + L * D, sn, WinT, D, dr, scr, F.lane);
            } else {
                tr_item(A.in[3] + (size_t)j * D * NIN_O, NIN_O, dr, 32, 64 * kb, A.in[6] + L * D, nullptr, WinT, D, dr, scr, F.lane);
            }
            continue;
        }
        r -= I_IN;
        if (r < I_O) { if (!(which & 2)) continue; const int kb = r / 32, nb = r % 32; tr_item(A.in[4] + (size_t)L * D * D, D, 32 * nb, 32, 64 * kb, nullptr, nullptr, WoT, D, 32 * nb, scr, F.lane); continue; }
        r -= I_O;
        if (r < I_UP) { if (!(which & 4)) continue; const int kb = r / (NUP / 32), nb = r % (NUP / 32); const int p = nb >> 3, half = (nb >> 2) & 1, c0 = (nb & 3) * 32;
            tr_item(A.in[8] + (size_t)L * D * NUP, NUP, half * FF + 128 * p + c0, 32, 64 * kb, A.in[7] + L * D, nullptr, WupT, D, 32 * nb, scr, F.lane); continue; }
        r -= I_UP;
        if (which & 8) { const int kb = r / 32, nb = r % 32; tr_item(A.in[11] + (size_t)L * FF * D, D, 32 * nb, 32, 64 * kb, nullptr, nullptr, WdnT, FF, 32 * nb, scr, F.lane); }
    }
}
__device__ __forceinline__ void p0_prologue(Frame& F, const Args& A) {
    const int gw = F.vcu * NWAVES + F.wave, NGW = F.G * NWAVES;
    const float* x = A.in[0]; bf16* XB = (bf16*)(F.ws + WS_XB); float* SS0 = (float*)(F.ws + WS_SS) + (size_t)M * 4;
    for (int m = gw; m < M; m += NGW) {
        const GAS f32x4* xr = (const GAS f32x4*)(x + (size_t)m * D) + F.lane;
        f32x4 v[4]; float s = 0.f;
#pragma unroll
        for (int jj = 0; jj < 4; ++jj) { v[jj] = xr[64 * jj]; s += (v[jj].x * v[jj].x + v[jj].y * v[jj].y) + (v[jj].z * v[jj].z + v[jj].w * v[jj].w); }
        s = wave_sum(s);
        if (F.lane < 4) SS0[(size_t)m * 4 + F.lane] = F.lane == 0 ? s : 0.f;
        GAS unsigned long long* o8 = (GAS unsigned long long*)(XB + (size_t)m * D) + F.lane;
#pragma unroll
        for (int jj = 0; jj < 4; ++jj) o8[64 * jj] = (unsigned long long)pk2(v[jj].x, v[jj].y) | ((unsigned long long)pk2(v[jj].z, v[jj].w) << 32);
    }
    { float* CW = (float*)(F.ws + WS_CW);
        for (int i = F.vcu * (NWAVES * 64) + F.tid; i < DEPTH * 4 * NUP; i += F.G * NWAVES * 64) { const int l = i / (4 * NUP), r = i - l * 4 * NUP, row = r / NUP, c = r - row * NUP;
            const float v = row < 3 ? A.in[9][(size_t)l * 3 * NUP + (size_t)row * NUP + c] : A.in[10][(size_t)l * NUP + c];
            CW[i] = v * (c < FF ? -0.6931471805599453f : -1.4426950408889634f); } }
    convert_layer(F, A, 0, F.vcu * NWAVES + F.wave, F.G * NWAVES, 1);
}
__device__ __forceinline__ void final_norm(Frame& F, const Args& A) {
    const int gw = F.vcu * NWAVES + F.wave, NGW = F.G * NWAVES;
    const float* SS = (const float*)(F.ws + WS_SS) + (size_t)M * 4; const GAS f32x4* g4 = (const GAS f32x4*)A.in[12] + 2 * F.lane;
    const bf16* XB = (const bf16*)(F.ws + WS_XB);
    f32x4 g[4];
#pragma unroll
    for (int jj = 0; jj < 2; ++jj) { g[2 * jj] = g4[128 * jj]; g[2 * jj + 1] = g4[128 * jj + 1]; }
    for (int m = gw; m < M; m += NGW) {
        const GAS v4u* xr = (const GAS v4u*)(XB + (size_t)m * D) + F.lane; GAS f32x4* o = (GAS f32x4*)(F.out + (size_t)m * D) + 2 * F.lane;
        const float rs = pg8::row_rstd(SS, m);
#pragma unroll
        for (int jj = 0; jj < 2; ++jj) { const v4u b = xr[64 * jj];
            f32x4 v0 = {__uint_as_float(b.x << 16), __uint_as_float(b.x & 0xffff0000u), __uint_as_float(b.y << 16), __uint_as_float(b.y & 0xffff0000u)};
            f32x4 v1 = {__uint_as_float(b.z << 16), __uint_as_float(b.z & 0xffff0000u), __uint_as_float(b.w << 16), __uint_as_float(b.w & 0xffff0000u)};
            o[128 * jj] = v0 * rs * g[2 * jj]; o[128 * jj + 1] = v1 * rs * g[2 * jj + 1]; }
    }
}
__device__ __forceinline__ void fix_rows(Frame& F, const Args& A, int pm, int L) {
    const float* UE = (const float*)(F.ws + WS_UE); bf16* G = (bf16*)(F.ws + WS_G);
    const float* cw = A.in[9] + (size_t)L * 3 * NUP; const float* cb = A.in[10] + (size_t)L * NUP;
    const float* um2 = UE + ((size_t)(pm - 1) * 4 + 2) * NUP; const float* um1 = um2 + NUP; const float* u0 = UE + (size_t)pm * 4 * NUP; const float* u1 = u0 + NUP;
    constexpr int NQ = FF / 4;
#define FIX_LD(p_) (*(const GAS f32x4*)(p_))
    f32x4 wv[2][8], uv[2][8];
#pragma unroll
    for (int k = 0; k < 2; ++k) { const int q = F.tid + k * (NWAVES * 64), c = 4 * (q < NQ ? q : 0), iv = (c >> 7) * 256 + (c & 127), ig = iv + 128;
        wv[k][0] = FIX_LD(cw + c); wv[k][1] = FIX_LD(cw + NUP + c); wv[k][2] = FIX_LD(cw + 2 * NUP + c); wv[k][3] = FIX_LD(cb + c);
        wv[k][4] = FIX_LD(cw + FF + c); wv[k][5] = FIX_LD(cw + NUP + FF + c); wv[k][6] = FIX_LD(cw + 2 * NUP + FF + c); wv[k][7] = FIX_LD(cb + FF + c);
        uv[k][0] = FIX_LD(um2 + iv); uv[k][1] = FIX_LD(um1 + iv); uv[k][2] = FIX_LD(u0 + iv); uv[k][3] = FIX_LD(u1 + iv);
        uv[k][4] = FIX_LD(um2 + ig); uv[k][5] = FIX_LD(um1 + ig); uv[k][6] = FIX_LD(u0 + ig); uv[k][7] = FIX_LD(u1 + ig); }
#undef FIX_LD
#pragma unroll
    for (int k = 0; k < 2; ++k) { const int q = F.tid + k * (NWAVES * 64);
        if (q < NQ) { const int c = 4 * q; unsigned g0[4], g1[4];
#pragma unroll
            for (int e = 0; e < 4; ++e) {
                const float w0v = wv[k][0][e], w1v = wv[k][1][e], w2v = wv[k][2][e], bv = wv[k][3][e], w0g = wv[k][4][e], w1g = wv[k][5][e], w2g = wv[k][6][e], bg = wv[k][7][e];
                const float a2v = uv[k][0][e], a1v = uv[k][1][e], a0v = uv[k][2][e], b0v = uv[k][3][e], a2g = uv[k][4][e], a1g = uv[k][5][e], a0g = uv[k][6][e], b0g = uv[k][7][e];
                float cv = bv + w0v * a2v + w1v * a1v + w2v * a0v, cg = bg + w0g * a2g + w1g * a1g + w2g * a0g;
                g0[e] = f2bf(cv * cg * __builtin_amdgcn_rcpf(1.0f + __builtin_amdgcn_exp2f(-cg * LOG2E)));
                cv = bv + w0v * a1v + w1v * a0v + w2v * b0v; cg = bg + w0g * a1g + w1g * a0g + w2g * b0g;
                g1[e] = f2bf(cv * cg * __builtin_amdgcn_rcpf(1.0f + __builtin_amdgcn_exp2f(-cg * LOG2E))); }
            *(GAS unsigned long long*)(G + (size_t)(pm * 256) * FF + c) = (unsigned long long)(g0[0] | (g0[1] << 16)) | ((unsigned long long)(g0[2] | (g0[3] << 16)) << 32);
            *(GAS unsigned long long*)(G + (size_t)(pm * 256 + 1) * FF + c) = (unsigned long long)(g1[0] | (g1[1] << 16)) | ((unsigned long long)(g1[2] | (g1[3] << 16)) << 32); } }
}

typedef __bf16 bf16x2_t __attribute__((ext_vector_type(2)));
__device__ __forceinline__ float dot2bf(unsigned a, unsigned b, float c) { return __builtin_amdgcn_fdot2_f32_bf16(__builtin_bit_cast(bf16x2_t, a), __builtin_bit_cast(bf16x2_t, b), c, false); }
__device__ __forceinline__ float bflo(unsigned w) { return __uint_as_float(w << 16); }
__device__ __forceinline__ float bfhi(unsigned w) { return __uint_as_float(w & 0xffff0000u); }
struct LaneAcc { float m, l; f32x4 o[16]; };
__device__ __forceinline__ void la_init(LaneAcc& A) { A.m = -INFINITY; A.l = 0.f;
#pragma unroll
    for (int i = 0; i < 16; ++i) A.o[i] = (f32x4){0.f, 0.f, 0.f, 0.f}; }
__device__ __forceinline__ void la_key(LaneAcc& A, const v4u (&q)[8], const bf16* krow, const bf16* vrow, float bias2) {
    v4u k[8];
#pragma unroll
    for (int i = 0; i < 8; ++i) k[i] = *(const GAS v4u*)(krow + 8 * i);
    float s0 = 0.f, s1 = 0.f, s2 = 0.f, s3 = 0.f;
#pragma unroll
    for (int i = 0; i < 8; ++i) { s0 = dot2bf(q[i].x, k[i].x, s0); s1 = dot2bf(q[i].y, k[i].y, s1); s2 = dot2bf(q[i].z, k[i].z, s2); s3 = dot2bf(q[i].w, k[i].w, s3); }
    const float s = (s0 + s1) + (s2 + s3) + bias2;
    if (s > A.m) { const float f = __builtin_amdgcn_exp2f(A.m - s); A.l *= f;
#pragma unroll
        for (int i = 0; i < 16; ++i) A.o[i] *= f;
        A.m = s; }
    const float p = __builtin_amdgcn_exp2f(s - A.m); A.l += p;
    v4u v[8];
#pragma unroll
    for (int i = 0; i < 8; ++i) v[i] = *(const GAS v4u*)(vrow + 8 * i);
#pragma unroll
    for (int i = 0; i < 8; ++i) {
        A.o[2 * i] += p * (f32x4){bflo(v[i].x), bfhi(v[i].x), bflo(v[i].y), bfhi(v[i].y)};
        A.o[2 * i + 1] += p * (f32x4){bflo(v[i].z), bfhi(v[i].z), bflo(v[i].w), bfhi(v[i].w)};
    }
}
__device__ __forceinline__ void la_finish(LaneAcc& A, bf16* orow, int lane) {
    const float Mx = wave_max(A.m);
    const float f = (A.m == -INFINITY) ? 0.f : __builtin_amdgcn_exp2f(A.m - Mx);
    const float Lt = wave_sum(A.l * f); const float inv = 1.0f / Lt;
#pragma unroll
    for (int i = 0; i < 16; ++i) { f32x4 t = A.o[i] * f; t[0] = wave_sum(t[0]); t[1] = wave_sum(t[1]); t[2] = wave_sum(t[2]); t[3] = wave_sum(t[3]); A.o[i] = t * inv; }
    if (lane == 0) {
#pragma unroll
        for (int i = 0; i < 8; ++i) { v4u w; w.x = pk2(A.o[2 * i][0], A.o[2 * i][1]); w.y = pk2(A.o[2 * i][2], A.o[2 * i][3]); w.z = pk2(A.o[2 * i + 1][0], A.o[2 * i + 1][1]); w.w = pk2(A.o[2 * i + 1][2], A.o[2 * i + 1][3]);
            *(GAS v4u*)(orow + 8 * i) = w; }
    }
}
__device__ __forceinline__ float rel_bias2(const float* rb, int h, int d) { return rb[t5_bucket(d) * 16 + h] * LOG2E; }

__device__ __forceinline__ void simple_moba(Frame& F, const Args& A, int layer_j) {
    const int gw = F.vcu * NWAVES + F.wave, NGW = F.G * NWAVES, lane = F.lane;
    bf16* Q = (bf16*)(F.ws + WS_Q); const bf16* K = (const bf16*)(F.ws + WS_K); const bf16* V = (const bf16*)(F.ws + WS_V);
    const float* KM = (const float*)(F.ws + WS_KM); const float* rb = A.in[5];
    for (int task = gw; task < M * 8; task += NGW) {
        const int h = task & 7, row = task >> 3, b = row >> 12, t = row & 4095, own = t >> 8;
        bf16* qrow = Q + (size_t)row * D + h * HD;
        v4u q[8];
#pragma unroll
        for (int i = 0; i < 8; ++i) q[i] = *(const GAS v4u*)(qrow + 8 * i);
        float g = -INFINITY;
        if (lane < own) { const GAS f32x4* km = (const GAS f32x4*)(KM + ((size_t)((b * 8 + h) * 16 + lane)) * 128); float a = 0.f;
#pragma unroll
            for (int i = 0; i < 8; ++i) { const f32x4 k0 = km[2 * i] + km[16 + 2 * i], k1 = km[2 * i + 1] + km[16 + 2 * i + 1];
                a += bflo(q[i].x) * k0[0] + bfhi(q[i].x) * k0[1] + bflo(q[i].y) * k0[2] + bfhi(q[i].y) * k0[3] + bflo(q[i].z) * k1[0] + bfhi(q[i].z) * k1[1] + bflo(q[i].w) * k1[2] + bfhi(q[i].w) * k1[3]; }
            g = a; }
        int sel0 = -1, sel1 = -1, sel2 = -1, nsel = 0;
#pragma unroll
        for (int r = 0; r < 3; ++r) { const float mx = wave_max(g);
            if (mx > -INFINITY) { const unsigned long long bal = __ballot(g == mx); const int idx = __ffsll((long long)bal) - 1;
                if (r == 0) sel0 = idx; else if (r == 1) sel1 = idx; else sel2 = idx; nsel = r + 1; if (lane == idx) g = -INFINITY; } }
        const int nown = t - own * 256 + 1, ntot = nsel * 256 + nown;
        LaneAcc A; la_init(A);
        for (int e = lane; e < ntot; e += 64) {
            const int bi = e >> 8; const int blk = bi < nsel ? (bi == 0 ? sel0 : (bi == 1 ? sel1 : sel2)) : own;
            const int s = blk * 256 + (e & 255); const size_t kr = (size_t)(b * SEQ + s) * D + h * HD;
            la_key(A, q, K + kr, V + kr, rel_bias2(rb, h, t - s));
        }
        la_finish(A, qrow, lane);
    }
}
__device__ __forceinline__ void simple_dsa(Frame& F, const Args& A) {
    const int gw = F.vcu * NWAVES + F.wave, NGW = F.G * NWAVES, lane = F.lane;
    bf16* Q = (bf16*)(F.ws + WS_Q); const bf16* K = (const bf16*)(F.ws + WS_K); const bf16* V = (const bf16*)(F.ws + WS_V);
    const unsigned long long* MASK = (const unsigned long long*)(F.ws + WS_MASK); const float* rb = A.in[5];
    for (int task = gw; task < M * 8; task += NGW) {
        const int h = 8 + (task & 7), row = task >> 3, b = row >> 12, t = row & 4095;
        bf16* qrow = Q + (size_t)row * D + h * HD;
        v4u q[8];
#pragma unroll
        for (int i = 0; i < 8; ++i) q[i] = *(const GAS v4u*)(qrow + 8 * i);
        unsigned long long w = MASK[(size_t)row * 64 + lane];
        LaneAcc A; la_init(A);
        while (w) { const int bit = __ffsll((long long)w) - 1; w &= w - 1; const int s = lane * 64 + bit;
            if (s <= t) { const size_t kr = (size_t)(b * SEQ + s) * D + h * HD; la_key(A, q, K + kr, V + kr, rel_bias2(rb, h, t - s)); } }
        la_finish(A, qrow, lane);
    }
}
__device__ __forceinline__ void simple_dilated(Frame& F, const Args& A) {
    const int gw = F.vcu * NWAVES + F.wave, NGW = F.G * NWAVES, lane = F.lane;
    bf16* Q = (bf16*)(F.ws + WS_Q); const bf16* K = (const bf16*)(F.ws + WS_K); const bf16* V = (const bf16*)(F.ws + WS_V); const float* rb = A.in[5];
    for (int task = gw; task < M * 16; task += NGW) {
        const int h = task & 15, row = task >> 4, b = row >> 12, t = row & 4095;
        bf16* qrow = Q + (size_t)row * D + h * HD;
        v4u q[8];
#pragma unroll
        for (int i = 0; i < 8; ++i) q[i] = *(const GAS v4u*)(qrow + 8 * i);
        LaneAcc A; la_init(A);
        for (int e = lane; e < 387; e += 64) { const int p = e / 129, i = e - 129 * p, d = i << (2 * p), s = t - d;
            if (s >= 0) { const size_t kr = (size_t)(b * SEQ + s) * D + h * HD; la_key(A, q, K + kr, V + kr, rel_bias2(rb, h, d)); } }
        la_finish(A, qrow, lane);
    }
}
__device__ __forceinline__ unsigned f2key(float f) { const unsigned u = __float_as_uint(f); return (u & 0x80000000u) ? ~u : (u | 0x80000000u); }
__device__ __forceinline__ void select_row(LAS float* sc, LAS unsigned* hist, int t, int row, unsigned long long* MASK, int lane) {
    const int nj = (t >> 6) + 1;
    unsigned thr = 0u; int need_eq = 0x7fffffff;
    if (t + 1 > 256) {
        unsigned prefix = 0u; int kk = 256;
#pragma unroll 1
        for (int pass = 0; pass < 4; ++pass) { const int sh = 24 - 8 * pass;
            hist[lane] = 0u; hist[64 + lane] = 0u; hist[128 + lane] = 0u; hist[192 + lane] = 0u;
            LDS_WAIT(); asm volatile("" ::: "memory");
            for (int jj = 0; jj < nj; ++jj) { const int s = jj * 64 + lane; const unsigned key = f2key(sc[s]);
                const bool in = (s <= t) && (pass == 0 || (key >> (sh + 8)) == prefix);
                if (in) __hip_atomic_fetch_add(hist + ((key >> sh) & 255u), 1u, __ATOMIC_RELAXED, __HIP_MEMORY_SCOPE_WORKGROUP); }
            LDS_WAIT(); asm volatile("" ::: "memory");
            const unsigned c0 = hist[4 * lane], c1 = hist[4 * lane + 1], c2 = hist[4 * lane + 2], c3 = hist[4 * lane + 3];
            const int ls = (int)(c0 + c1 + c2 + c3);
            int suf = ls;
#pragma unroll
            for (int o = 1; o < 64; o <<= 1) { const int v = __shfl_down(suf, o); if (lane + o < 64) suf += v; }
            const int above = suf - ls;
            const bool mine = (above < kk) && (suf >= kk);
            const unsigned long long bal = __ballot(mine); const int src = __ffsll((long long)bal) - 1;
            int bsel = 0, krem = kk;
            { int acc = above; if (acc + (int)c3 >= kk) { bsel = 3; krem = kk - acc; } else { acc += (int)c3; if (acc + (int)c2 >= kk) { bsel = 2; krem = kk - acc; } else { acc += (int)c2;
                  if (acc + (int)c1 >= kk) { bsel = 1; krem = kk - acc; } else { acc += (int)c1; bsel = 0; krem = kk - acc; } } } }
            bsel = __shfl(bsel + 4 * lane, src); krem = __shfl(krem, src);
            prefix = (prefix << 8) | (unsigned)bsel; kk = krem;
            LDS_WAIT(); asm volatile("" ::: "memory");
        }
        thr = prefix; need_eq = kk;
    }
    unsigned long long myword = 0ull;
    for (int jj = 0; jj < nj; ++jj) { const int s = jj * 64 + lane; const unsigned key = f2key(sc[s]); const bool valid = s <= t;
        unsigned long long gt = __ballot(valid && (t + 1 <= 256 || key > thr));
        if (t + 1 > 256 && need_eq > 0) { unsigned long long eq = __ballot(valid && key == thr); int c = __popcll(eq);
            while (c > need_eq) { eq &= ~(1ull << (63 - __clzll((long long)eq))); --c; }
            gt |= eq; need_eq -= c; }
        if (lane == jj) myword = gt; }
    MASK[(size_t)row * 64 + lane] = myword;
}
__device__ __forceinline__ void simple_indexer(Frame& F, int layer_j) {
    const int gw = F.vcu * NWAVES + F.wave, NGW = F.G * NWAVES, lane = F.lane;
    const bf16* QI = (const bf16*)(F.ws + WS_QI); const bf16* KIB = (const bf16*)(F.ws + WS_KIB); const float* WI = (const float*)(F.ws + WS_WI);
    unsigned long long* MASK = (unsigned long long*)(F.ws + WS_MASK);
    LAS float* sc = (LAS float*)(F.lds + RING_OFF) + F.wave * 4096;
    LAS v4u* qs = (LAS v4u*)(F.lds + AUX_OFF + F.wave * 2048);
    LAS unsigned* hist = (LAS unsigned*)(F.lds + AUX_OFF + F.wave * 2048);
    for (int row = gw; row < M; row += NGW) {
        const int b = row >> 12, t = row & 4095, nj = (t >> 6) + 1;
        { const GAS v4u* src = (const GAS v4u*)(QI + (size_t)row * D); qs[lane] = src[lane]; qs[64 + lane] = src[64 + lane]; }
        f32x4 w4[4];
#pragma unroll
        for (int i = 0; i < 4; ++i) w4[i] = *(const GAS f32x4*)(WI + (size_t)row * 16 + 4 * i);
        LDS_WAIT(); asm volatile("" ::: "memory");
        for (int jj = 0; jj < nj; ++jj) {
            const int s = jj * 64 + lane; const size_t kr = (size_t)(b * SEQ + s);
            v4u k[8];
#pragma unroll
            for (int i = 0; i < 8; ++i) k[i] = *(const GAS v4u*)(KIB + kr * 64 + 8 * i);
            float score = 0.f;
#pragma unroll
            for (int h = 0; h < 16; ++h) { float a0 = 0.f, a1 = 0.f;
#pragma unroll
                for (int i = 0; i < 8; ++i) { const v4u qq = qs[h * 8 + i]; a0 = dot2bf(qq.x, k[i].x, a0); a1 = dot2bf(qq.y, k[i].y, a1); a0 = dot2bf(qq.z, k[i].z, a0); a1 = dot2bf(qq.w, k[i].w, a1); }
                score += fmaxf(a0 + a1, 0.f) * w4[h >> 2][h & 3]; }
            sc[s] = (s <= t) ? score : -INFINITY;
        }
        LDS_WAIT(); asm volatile("" ::: "memory");
        select_row(sc, hist, t, row, MASK, lane);
        LDS_WAIT(); asm volatile("" ::: "memory");
    }
}

namespace attn_body {
using bf16=__hip_bfloat16;
using bf16x8=__attribute__((ext_vector_type(8)))short;
using s16x4=__attribute__((ext_vector_type(4)))short;
using f32x16=__attribute__((ext_vector_type(16)))float;
using u32x4=__attribute__((ext_vector_type(4)))unsigned;
constexpr int BATCH=4,NHEAD=16,SEQ=4096,D=64,DM=NHEAD*D;
constexpr int NW=8,QBLK=32,QB=QBLK*NW,KVBLK=64,NQB=SEQ/QB;
constexpr int ATTN_PITCH=DM, ATTN_UNIT_ROWS=QB;
__device__ __forceinline__ int crow(int r,int hi){return (r&3)+8*(r>>2)+4*hi;}
#define SBAR() __builtin_amdgcn_sched_barrier(0)
__device__ __forceinline__ void cmask(f32x16&p0,f32x16&p1,int jb,int qrel,int hi){
  const float NEG=-INFINITY; int kb=64*jb+4*hi;
  #pragma unroll
  for(int r=0;r<16;++r){int kv=kb+(r&3)+8*(r>>2); if(kv>qrel)p0[r]=NEG; if(kv+32>qrel)p1[r]=NEG;}
}

constexpr int NSLOT=3, SLOTB=8192;
constexpr int LDS_K=0, LDS_V=NSLOT*SLOTB, LDS_WS=2*NSLOT*SLOTB, LDS_OST=LDS_WS+NW*64*4, LDS_LT=LDS_OST+NW*4096, LDS_MK=LDS_LT+2560*4, LDS_KM=LDS_MK+NW*768, LDS_BYTES=LDS_KM+4096;
constexpr float C2=::C2;
__device__ __forceinline__ void glds16(const void*gsrc,unsigned lds_dst){unsigned keep;
  asm volatile("s_mov_b32 %0, m0\n\ts_mov_b32 m0, %2\n\ts_nop 0\n\tglobal_load_lds_dwordx4 %1, off\n\ts_mov_b32 m0, %0":"=&s"(keep):"v"(gsrc),"s"(lds_dst):"memory");}
__device__ __forceinline__ void glds4(const void*gsrc,unsigned lds_dst){unsigned keep;
  asm volatile("s_mov_b32 %0, m0\n\ts_mov_b32 m0, %2\n\ts_nop 0\n\tglobal_load_lds_dword %1, off\n\ts_mov_b32 m0, %0":"=&s"(keep):"v"(gsrc),"s"(lds_dst):"memory");}
__device__ __forceinline__ float max3f(float a,float b,float c){float r;asm("v_max3_f32 %0, %1, %2, %3":"=v"(r):"v"(a),"v"(b),"v"(c));return r;}
__device__ __forceinline__ float max2f(float a,float b){float r;asm("v_max_f32_e32 %0, %1, %2":"=v"(r):"v"(a),"v"(b));return r;}
__device__ __forceinline__ float fadd_s(float a,float b){float r;asm("v_add_f32_e32 %0, %1, %2":"=v"(r):"v"(a),"v"(b));return r;}
__device__ __forceinline__ float fsub_s(float a,float b){float r;asm("v_sub_f32_e32 %0, %1, %2":"=v"(r):"v"(a),"v"(b));return r;}
typedef float f32x4_t __attribute__((ext_vector_type(4))); __device__ __forceinline__ float bf2f(short v){return __uint_as_float(((unsigned)(unsigned short)v)<<16);}
typedef float f32x2_t __attribute__((ext_vector_type(2))); typedef __bf16 bf16x2_t __attribute__((ext_vector_type(2)));
__device__ __forceinline__ unsigned cvtpk_s(float lo,float hi){f32x2_t v={lo,hi};bf16x2_t b=__builtin_convertvector(v,bf16x2_t);return __builtin_bit_cast(unsigned,b);}
#define WAIT_BAR(N) asm volatile("s_waitcnt vmcnt(" #N ") lgkmcnt(0)\n\ts_barrier":::"memory")

__device__ __forceinline__ void qkt(f32x16&p0,f32x16&p1,const char*Kslot,const bf16x8*qr,const f32x16&negm,int r32,int hi){
  const char*kb=Kslot+hi*1024+r32*16;
  #pragma unroll
  for(int d0=0;d0<4;++d0){
    const bf16x8 b0=*reinterpret_cast<const bf16x8*>(kb+d0*2048);
    const bf16x8 b1=*reinterpret_cast<const bf16x8*>(kb+d0*2048+512);
    if(d0==0){p0=__builtin_amdgcn_mfma_f32_32x32x16_bf16(b0,qr[0],negm,0,0,0);p1=__builtin_amdgcn_mfma_f32_32x32x16_bf16(b1,qr[0],negm,0,0,0);}
    else{p0=__builtin_amdgcn_mfma_f32_32x32x16_bf16(b0,qr[d0],p0,0,0,0);p1=__builtin_amdgcn_mfma_f32_32x32x16_bf16(b1,qr[d0],p1,0,0,0);}}
}
typedef __attribute__((address_space(3))) const char* lds_cptr;
typedef short v4i16_t __attribute__((ext_vector_type(4)));
__device__ __forceinline__ void kload8(bf16x8*kf,lds_cptr kp){
  kf[0]=*(const __attribute__((address_space(3))) bf16x8*)(kp);      kf[1]=*(const __attribute__((address_space(3))) bf16x8*)(kp+512);
  kf[2]=*(const __attribute__((address_space(3))) bf16x8*)(kp+2048); kf[3]=*(const __attribute__((address_space(3))) bf16x8*)(kp+2560);
  kf[4]=*(const __attribute__((address_space(3))) bf16x8*)(kp+4096); kf[5]=*(const __attribute__((address_space(3))) bf16x8*)(kp+4608);
  kf[6]=*(const __attribute__((address_space(3))) bf16x8*)(kp+6144); kf[7]=*(const __attribute__((address_space(3))) bf16x8*)(kp+6656);
}
__device__ __forceinline__ void kload2(bf16x8*kf,lds_cptr kp,int j){ kf[2*j]=*(const __attribute__((address_space(3))) bf16x8*)(kp+j*2048); kf[2*j+1]=*(const __attribute__((address_space(3))) bf16x8*)(kp+j*2048+512); }
__device__ __forceinline__ s16x4 vtr(lds_cptr p){ return __builtin_bit_cast(s16x4,__builtin_amdgcn_ds_read_tr16_b64_v4i16((__attribute__((address_space(3))) v4i16_t*)p)); }
__device__ __forceinline__ float rowmax(const f32x16&p0,const f32x16&p1){
  float a=max3f(p0[0],p0[1],p1[0]),b=max3f(p0[2],p0[3],p1[1]);a=max3f(a,p1[2],p1[3]);
  #pragma unroll
  for(int r=4;r<16;r+=4){a=max3f(a,p0[r],p0[r+1]);b=max3f(b,p0[r+2],p0[r+3]);a=max3f(a,p1[r],p1[r+1]);b=max3f(b,p1[r+2],p1[r+3]);}
  const float m=max2f(a,b);
  auto rr=__builtin_amdgcn_permlane32_swap(__float_as_uint(m),__float_as_uint(m),false,false);
  return max2f(__uint_as_float(rr[0]),__uint_as_float(rr[1]));
}
__device__ __forceinline__ void pv(f32x16*o,int vb,bf16x8 pa0,bf16x8 pa1,bf16x8 pa2,bf16x8 pa3){
  #pragma unroll
  for(int d0=0;d0<2;++d0){s16x4 lo[4],hi[4];
    #pragma unroll
    for(int ks=0;ks<4;++ks){
      asm volatile("ds_read_b64_tr_b16 %0,%1 offset:%c2":"=&v"(lo[ks]):"v"(vb),"i"(d0*4096+ks*1024):"memory");
      asm volatile("ds_read_b64_tr_b16 %0,%1 offset:%c2":"=&v"(hi[ks]):"v"(vb),"i"(d0*4096+ks*1024+512):"memory");}
    asm volatile("s_waitcnt lgkmcnt(0)":::"memory");SBAR();
    #define PK(k) (bf16x8){lo[k][0],lo[k][1],lo[k][2],lo[k][3],hi[k][0],hi[k][1],hi[k][2],hi[k][3]}
    o[d0]=__builtin_amdgcn_mfma_f32_32x32x16_bf16(pa0,PK(0),o[d0],0,0,0);
    o[d0]=__builtin_amdgcn_mfma_f32_32x32x16_bf16(pa1,PK(1),o[d0],0,0,0);
    o[d0]=__builtin_amdgcn_mfma_f32_32x32x16_bf16(pa2,PK(2),o[d0],0,0,0);
    o[d0]=__builtin_amdgcn_mfma_f32_32x32x16_bf16(pa3,PK(3),o[d0],0,0,0);
    #undef PK
  }
}

#ifndef ATTN_STORE16
#define ATTN_STORE16(p,v) asm volatile("global_store_dwordx4 %0, %1, off sc0 sc1\n\ts_nop 1"::"v"(p),"v"(v):"memory")
#endif
template<int MODE,int THRL> __device__ __forceinline__ void attn_unit(int b,int h,int qb,const bf16*Q,const bf16*__restrict__ K,const bf16*__restrict__ V,bf16*O,char*shm,const int wid,const float*rb,const float*KM,const unsigned*MASK32,const bool build_tab){
  const int lane=hw_lane(),tid=wid*64+lane,r32=lane&31,hi=lane>>5;
  constexpr int DTOP=(MODE==2)?2303:383, TSZ=(MODE==2)?2560:640;
  const long rowbase=(long)b*SEQ; const int q0=qb*QB;
  const bf16*Qw=Q+(rowbase+q0+wid*QBLK)*DM+h*D;
  const int T0=(MODE==2&&qb>8)?4*(qb-8):0;
  const bf16*Kh=K+(rowbase+T0*KVBLK)*DM+h*D,*Vh=V+(rowbase+T0*KVBLK)*DM+h*D;
  const unsigned lds0=(unsigned)(uintptr_t)shm;
  float*wsf=(float*)(shm+LDS_WS)+wid*64;
  const bf16*ksrc=Kh+(long)lane*DM+wid*8;
  const bf16*vsrc=Vh+(long)(16*(wid&3)+(lane>>2))*DM+(wid>>2)*32+(lane&3)*8;
  const unsigned kdst=lds0+LDS_K+wid*1024, vdst=lds0+LDS_V+wid*1024;
  #define DMA_K(t,slot) glds16(ksrc+(long)(t)*KVBLK*DM,(unsigned)__builtin_amdgcn_readfirstlane(kdst+(slot)))
  #define DMA_V(t,slot) glds16(vsrc+(long)(t)*KVBLK*DM,(unsigned)__builtin_amdgcn_readfirstlane(vdst+(slot)))
  const int vb0=(int)(lds0+LDS_V)+((lane>>4)&1)*32+(lane&3)*8+(4*hi+((lane&15)>>2))*64;
  const char*Kbase=shm+LDS_K; bf16x8 kf[8];
  const lds_cptr shm3=(lds_cptr)shm; const lds_cptr kp0=shm3+LDS_K+hi*1024+r32*16; const lds_cptr vp0=shm3+LDS_V+((lane>>4)&1)*32+(lane&3)*8+(4*hi+((lane&15)>>2))*64;
  const int NT=(q0+QB)/KVBLK-T0;
  if(build_tab){ float*lt=(float*)(shm+LDS_LT); const float b31=rb[31*16+h];
    for(int i=tid;i<TSZ;i+=NW*64){ const int d=DTOP-i; float v;
      if(d<0)v=-INFINITY; else{ const float nb=(d<113)?(rb[t5_bucket(d)*16+h]-b31)*LOG2E:0.f;
        if(MODE==2){ const int m=(d<=128?1:0)+(((d&3)==0&&d<=512)?1:0)+(((d&15)==0&&d<=2048)?1:0); v=(m==0)?-INFINITY:nb+(m==1?0.f:(m==2?1.f:1.5849625007f)); } else v=nb; }
      lt[i]=v; } }
  if(MODE==0&&build_tab){ float*kms=(float*)(shm+LDS_KM);
    for(int i=tid;i<16*64;i+=NW*64){ const float*p=KM+((size_t)((b*8+h)*16+(i>>6)))*128+(i&63); kms[i]=p[0]+p[64]; } }
  const unsigned*msrc=MASK32+((size_t)(rowbase+q0+wid*QBLK+(lane>>1)))*128+(lane&1);
  const unsigned mdst=lds0+LDS_MK+wid*768;
  #define DMA_M(t,off) glds4(msrc+2*(t),(unsigned)__builtin_amdgcn_readfirstlane(mdst+(off)))
  #define WAITB(n2,n3) do{ if(MODE==1){WAIT_BAR(n3);}else{WAIT_BAR(n2);} }while(0)
  if(MODE==1){DMA_M(0,0);DMA_M(1,256);}
  DMA_K(0,0);DMA_V(0,0);DMA_K(1,SLOTB);
  bf16x8 qr[4];
  #pragma unroll
  for(int d0=0;d0<4;++d0)qr[d0]=*(const __attribute__((address_space(1))) bf16x8*)(&Qw[(long)r32*DM+d0*16+hi*8]);
  float mhat=0.f,l_reg=0.f;f32x16 o[2];o[0]=f32x16{};o[1]=f32x16{};f32x16 negm=f32x16{};asm volatile("":"+v"(negm));
  const int qrel=wid*QBLK+r32;
  unsigned selmask=0u;
  const lds_cptr ltb=shm3+LDS_LT+4*(DTOP-64*(NT-4)-qrel+4*hi);
  const lds_cptr mkb=shm3+LDS_MK+wid*768+r32*8;
  #define HOOK_TAB(P0,P1,t) do{ const lds_cptr lp_=ltb+256*(t); \
      _Pragma("unroll") for(int r=0;r<16;++r){ P0[r]+=*(const __attribute__((address_space(3))) float*)(lp_+4*((r&3)+8*(r>>2))); P1[r]+=*(const __attribute__((address_space(3))) float*)(lp_+4*((r&3)+8*(r>>2)+32)); } }while(0)
  #define HOOK_SEL(P0,P1,t) do{ if(MODE==0){ if((t)<NT-4){ if(!((selmask>>((t)>>2))&1u)){ _Pragma("unroll") for(int r=0;r<16;++r){P0[r]=-INFINITY;P1[r]=-INFINITY;} } } } \
      if(MODE==1){ const unsigned long long w_=*(const __attribute__((address_space(3))) unsigned long long*)(mkb+(sl_cur>>5)); const unsigned lo_=((unsigned)w_)>>(4*hi), hi_=((unsigned)(w_>>32))>>(4*hi);     \
        _Pragma("unroll") for(int r=0;r<16;++r){ const unsigned m0_=(unsigned)__builtin_amdgcn_sbfe((int)lo_,(r&3)+8*(r>>2),1), m1_=(unsigned)__builtin_amdgcn_sbfe((int)hi_,(r&3)+8*(r>>2),1);     \
          P0[r]=__uint_as_float((__float_as_uint(P0[r])&m0_)|(~m0_&0xFF800000u)); P1[r]=__uint_as_float((__float_as_uint(P1[r])&m1_)|(~m1_&0xFF800000u)); } } }while(0)
  #define CMASK(P0,P1,t) do{ HOOK_SEL(P0,P1,t); if(MODE==2||(t)>=NT-6)HOOK_TAB(P0,P1,t); }while(0)
  bool resc=false;
  #define START(P0,P1) do{ const float rm=rowmax(P0,P1); resc=false; \
    { const float dl=__builtin_fmaxf(rm,0.f); mhat=fadd_s(mhat,dl); \
      _Pragma("unroll") for(int r=0;r<16;++r){P0[r]=fsub_s(P0[r],dl);P1[r]=fsub_s(P1[r],dl);} \
      _Pragma("unroll") for(int r=0;r<16;++r)negm[r]=-mhat; asm volatile("":"+v"(negm)); } \
    _Pragma("unroll") for(int r=0;r<16;++r)P0[r]=__builtin_amdgcn_exp2f(P0[r]); }while(0)
  #define RESC() do{ if(resc){ asm volatile("s_waitcnt lgkmcnt(0)":::"memory"); \
      _Pragma("unroll") for(int d_=0;d_<2;++d_) _Pragma("unroll") for(int r=0;r<16;++r)o[d_][r]*=wsf[crow(r,hi)]; } }while(0)
  f32x16 pA0,pA1,pB0,pB1;
  int sl_prev=0,sl_cur=0,sl_next=SLOTB;
  #define ROT() do{sl_prev=sl_cur;sl_cur=sl_next;sl_next=(sl_next==(NSLOT-1)*SLOTB)?0:sl_next+SLOTB;}while(0)
  DMA_K(2,2*SLOTB);
  WAIT_BAR(3);
  if(MODE==0){
    if(qb<=3)selmask=(1u<<qb)-1u;
    else{ float v1=-INFINITY,v2=-INFINITY,v3=-INFINITY; int i1=0,i2=0,i3=0; const lds_cptr kmb=shm3+LDS_KM+32*hi;
      for(int n=0;n<qb;++n){ float a=0.f;
        _Pragma("unroll") for(int d0=0;d0<4;++d0){ const f32x4_t k0=*(const __attribute__((address_space(3))) f32x4_t*)(kmb+n*256+d0*64), k1=*(const __attribute__((address_space(3))) f32x4_t*)(kmb+n*256+d0*64+16); const bf16x8 qq=qr[d0];
          a+=bf2f(qq[0])*k0[0]+bf2f(qq[1])*k0[1]+bf2f(qq[2])*k0[2]+bf2f(qq[3])*k0[3]+bf2f(qq[4])*k1[0]+bf2f(qq[5])*k1[1]+bf2f(qq[6])*k1[2]+bf2f(qq[7])*k1[3]; }
        a+=__shfl_xor(a,32);
        if(a>v1){v3=v2;i3=i2;v2=v1;i2=i1;v1=a;i1=n;} else if(a>v2){v3=v2;i3=i2;v2=a;i2=n;} else if(a>v3){v3=a;i3=n;} }
      selmask=(1u<<i1)|(1u<<i2)|(1u<<i3); } }
  qkt(pA0,pA1,Kbase,qr,negm,r32,hi);asm volatile("s_nop 15\n\ts_nop 7":"+v"(pA0),"+v"(pA1));CMASK(pA0,pA1,0);
  START(pA0,pA1);
  _Pragma("unroll") for(int r=0;r<16;++r)pA1[r]=__builtin_amdgcn_exp2f(pA1[r]);
  WAIT_BAR(0);
  DMA_K(3,0);DMA_V(1,SLOTB); if(MODE==1){DMA_M(2,512);}
  ROT();
  kload8(kf,kp0+sl_cur);
  WAITB(2,3);
  s16x4 vlo[8],vhi[8]; u32x4 pw0,pw1,pw2,pw3;
  #define PKW(P,B) cvtpk_s(P[B],P[B+1])
  #define PAF(k) __builtin_bit_cast(bf16x8,pw##k)
  #define VFR(i) (bf16x8){vlo[i][0],vlo[i][1],vlo[i][2],vlo[i][3],vhi[i][0],vhi[i][1],vhi[i][2],vhi[i][3]}
  #define PIN(x) asm volatile("":"+v"(x))
  #define MX3(a,b,c) __builtin_fmaxf(__builtin_fmaxf((a),(b)),(c))
  #define GAPA(MF,A0,A1,A2,A3,W0,W1,PW) do{ MF; sacc+=A0; sacc+=A1; sacc+=A2; sacc+=A3; PIN(sacc); W0; W1; PIN(PW); SBAR(); }while(0)
  #define EX(v) __builtin_amdgcn_exp2f(v)
  #define GAPB(MF,X,B) do{ MF; X[B]=EX(X[B]); X[B+1]=EX(X[B+1]); X[B+2]=EX(X[B+2]); X[B+3]=EX(X[B+3]); PIN(X); SBAR(); }while(0)
  #define VRD(i) do{ vlo[i]=vtr(vp_+(((i)>>2)*4096+((i)&3)*1024)); vhi[i]=vtr(vp_+(((i)>>2)*4096+((i)&3)*1024+512)); }while(0)
  #define KRD(G,j) do{ if(G){ kload2(kf,kp0+sl_next,j); SBAR(); } }while(0)
  #define STEP(C0,C1,P0,P1,t,GK,GV,GL) do{ SBAR(); \
    const lds_cptr vp_=vp0+sl_prev; \
    VRD(0); SBAR(); float sacc=(P0[0]+P0[1]); \
    GAPA(C0=__builtin_amdgcn_mfma_f32_32x32x16_bf16(kf[0],qr[0],negm,0,0,0), P0[2],P0[3],P0[4],P0[5],     pw0[0]=PKW(P0,0), pw0[1]=PKW(P0,2), pw0); \
    VRD(4); SBAR(); GAPA(C1=__builtin_amdgcn_mfma_f32_32x32x16_bf16(kf[1],qr[0],negm,0,0,0), P0[6],P0[7],P0[8],P0[9],     pw0[2]=PKW(P0,4), pw0[3]=PKW(P0,6), pw0); \
    VRD(1); SBAR(); GAPA(C0=__builtin_amdgcn_mfma_f32_32x32x16_bf16(kf[2],qr[1],C0,0,0,0),   P0[10],P0[11],P0[12],P0[13], pw1[0]=PKW(P0,8), pw1[1]=PKW(P0,10), pw1); \
    VRD(5); SBAR(); GAPA(C1=__builtin_amdgcn_mfma_f32_32x32x16_bf16(kf[3],qr[1],C1,0,0,0),   P0[14],P0[15],P1[0],P1[1],   pw1[2]=PKW(P0,12),pw1[3]=PKW(P0,14), pw1); \
    VRD(2); SBAR(); GAPA(C0=__builtin_amdgcn_mfma_f32_32x32x16_bf16(kf[4],qr[2],C0,0,0,0),   P1[2],P1[3],P1[4],P1[5],     pw2[0]=PKW(P1,0), pw2[1]=PKW(P1,2), pw2); \
    VRD(6); SBAR(); GAPA(C1=__builtin_amdgcn_mfma_f32_32x32x16_bf16(kf[5],qr[2],C1,0,0,0),   P1[6],P1[7],P1[8],P1[9],     pw2[2]=PKW(P1,4), pw2[3]=PKW(P1,6), pw2); \
    VRD(3); SBAR(); GAPA(C0=__builtin_amdgcn_mfma_f32_32x32x16_bf16(kf[6],qr[3],C0,0,0,0),   P1[10],P1[11],P1[12],P1[13], pw3[0]=PKW(P1,8), pw3[1]=PKW(P1,10), pw3); \
    VRD(7); SBAR(); GAPA(C1=__builtin_amdgcn_mfma_f32_32x32x16_bf16(kf[7],qr[3],C1,0,0,0),   P1[14],P1[15],0.f,0.f,       pw3[2]=PKW(P1,12),pw3[3]=PKW(P1,14), pw3); \
    l_reg+=sacc; \
    if(GK){DMA_K((t)+3,sl_cur);} if(GV){DMA_V((t)+1,sl_next);} if(MODE==1){ if((t)+2<NT){DMA_M((t)+2,sl_prev>>5);} } \
    CMASK(C0,C1,t); \
    { float a=MX3(C0[0],C0[1],C1[0]),b=MX3(C0[2],C0[3],C1[1]); a=MX3(a,C1[2],C1[3]); \
      _Pragma("unroll") for(int r=4;r<16;r+=4){a=MX3(a,C0[r],C0[r+1]);b=MX3(b,C0[r+2],C0[r+3]);a=MX3(a,C1[r],C1[r+1]);b=MX3(b,C1[r+2],C1[r+3]);} \
      float rm=__builtin_fmaxf(a,b); { auto rr=__builtin_amdgcn_permlane32_swap(__float_as_uint(rm),__float_as_uint(rm),false,false); rm=__builtin_fmaxf(__uint_as_float(rr[0]),__uint_as_float(rr[1])); } \
      resc=false; \
      if(__builtin_expect(__any(rm>(float)THRL),0)){ const float dl=__builtin_fmaxf(rm,0.f); mhat+=dl; \
        _Pragma("unroll") for(int r=0;r<16;++r){C0[r]-=dl;C1[r]-=dl;} \
        _Pragma("unroll") for(int r=0;r<16;++r)negm[r]=-mhat; asm volatile("":"+v"(negm)); \
        const float f=__builtin_amdgcn_exp2f(-dl); l_reg*=f; if(hi==0)wsf[r32]=f; resc=true; } } \
    SBAR(); \
    GAPB(o[0]=__builtin_amdgcn_mfma_f32_32x32x16_bf16(PAF(0),VFR(0),o[0],0,0,0), C0,0); \
    GAPB(o[1]=__builtin_amdgcn_mfma_f32_32x32x16_bf16(PAF(0),VFR(4),o[1],0,0,0), C0,4); \
    KRD(GL,0); GAPB(o[0]=__builtin_amdgcn_mfma_f32_32x32x16_bf16(PAF(1),VFR(1),o[0],0,0,0), C0,8); \
    KRD(GL,1); GAPB(o[1]=__builtin_amdgcn_mfma_f32_32x32x16_bf16(PAF(1),VFR(5),o[1],0,0,0), C0,12); \
    KRD(GL,2); GAPB(o[0]=__builtin_amdgcn_mfma_f32_32x32x16_bf16(PAF(2),VFR(2),o[0],0,0,0), C1,0); \
    KRD(GL,3); GAPB(o[1]=__builtin_amdgcn_mfma_f32_32x32x16_bf16(PAF(2),VFR(6),o[1],0,0,0), C1,4); \
    GAPB(o[0]=__builtin_amdgcn_mfma_f32_32x32x16_bf16(PAF(3),VFR(3),o[0],0,0,0), C1,8); \
    GAPB(o[1]=__builtin_amdgcn_mfma_f32_32x32x16_bf16(PAF(3),VFR(7),o[1],0,0,0), C1,12); \
    }while(0)
  int t=1;
  #undef CMASK
  #define CMASK(P0,P1,t) do{ HOOK_SEL(P0,P1,t); if(MODE==2)HOOK_TAB(P0,P1,t); }while(0)
  for(;t+7<NT;t+=2){
    STEP(pB0,pB1,pA0,pA1,t,true,true,true);     WAITB(2,3); RESC(); ROT();
    STEP(pA0,pA1,pB0,pB1,t+1,true,true,true);   WAITB(2,3); RESC(); ROT();
  }
  #undef CMASK
  #define CMASK(P0,P1,t) do{ HOOK_SEL(P0,P1,t); if(MODE==2||(t)>=NT-6)HOOK_TAB(P0,P1,t); }while(0)
  #define ENDW(tt) do{ if((tt)+3<NT){WAITB(2,3);} else if((tt)+2<NT){WAITB(1,2);} else {WAIT_BAR(0);} }while(0)
  for(;t+1<NT;t+=2){
    STEP(pB0,pB1,pA0,pA1,t,(t+3<NT),(t+1<NT),(t+1<NT));       ENDW(t);   RESC(); ROT();
    STEP(pA0,pA1,pB0,pB1,t+1,(t+4<NT),(t+2<NT),(t+2<NT));     ENDW(t+1); RESC(); ROT();
  }
  STEP(pB0,pB1,pA0,pA1,NT-1,false,false,false); RESC();
  { float sacc=pB0[0]+pB0[1]; _Pragma("unroll") for(int r=2;r<16;++r)sacc+=pB0[r]; _Pragma("unroll") for(int r=0;r<16;++r)sacc+=pB1[r]; l_reg+=sacc;
    pw0=(u32x4){PKW(pB0,0),PKW(pB0,2),PKW(pB0,4),PKW(pB0,6)};pw1=(u32x4){PKW(pB0,8),PKW(pB0,10),PKW(pB0,12),PKW(pB0,14)};pw2=(u32x4){PKW(pB1,0),PKW(pB1,2),PKW(pB1,4),PKW(pB1,6)};pw3=(u32x4){PKW(pB1,8),PKW(pB1,10),PKW(pB1,12),PKW(pB1,14)};
    SBAR(); pv(o,vb0+sl_cur,PAF(0),PAF(1),PAF(2),PAF(3)); }
  #undef PKW
  #undef PAF
  #undef VFR
  #undef PIN
  #undef MX3
  #undef GAPA
  #undef GAPB
  #undef EX
  #undef VRD
  #undef KRD
  #undef STEP
  #undef ENDW
  {auto rr=__builtin_amdgcn_permlane32_swap(__float_as_uint(l_reg),__float_as_uint(l_reg),false,false);l_reg=__uint_as_float(rr[0])+__uint_as_float(rr[1]);}
  if(hi==0)wsf[32+r32]=l_reg;asm volatile("s_waitcnt lgkmcnt(0)":::"memory");
  float rli[16];
  #pragma unroll
  for(int r=0;r<16;++r)rli[r]=__builtin_amdgcn_rcpf(wsf[32+crow(r,hi)]);
  bf16*Ow=O+(rowbase+q0+wid*QBLK)*DM+h*D;
  { bf16*stg=(bf16*)(shm+LDS_OST)+wid*2048;
    #pragma unroll
    for(int r=0;r<16;++r){const int orow=crow(r,hi);
      #pragma unroll
      for(int d0=0;d0<2;++d0)stg[orow*64+d0*32+r32]=__float2bfloat16(o[d0][r]*rli[r]);}
    asm volatile("s_waitcnt lgkmcnt(0)":::"memory");
    #pragma unroll
    for(int i=0;i<4;++i){const int row=i*8+(lane>>3),ch=lane&7; const u32x4 v=*(const u32x4*)(stg+row*64+ch*8); ATTN_STORE16(Ow+(long)row*DM+ch*8,v);} }
  asm volatile("s_waitcnt lgkmcnt(0)\n\ts_barrier":::"memory");
  #undef DMA_K
  #undef DMA_M
  #undef HOOK_TAB
  #undef HOOK_SEL
  #undef WAITB
  #undef DMA_V
  #undef CMASK
  #undef START
  #undef RESC
  #undef ROT
}
constexpr int ATTN_LDS_BYTES=LDS_BYTES;
#undef SBAR
#undef WAIT_BAR
}

__device__ __forceinline__ void hist_pick(const LAS unsigned* hist, int kk, int lane, int& bsel_out, int& krem_out) {
    typedef unsigned u32x4_t __attribute__((ext_vector_type(4)));
    const u32x4_t q = *((const LAS u32x4_t*)hist + lane); const unsigned c0 = q.x, c1 = q.y, c2 = q.z, c3 = q.w;
    const int ls = (int)(c0 + c1 + c2 + c3);
    int suf = ls;
#pragma unroll
    for (int o = 1; o < 64; o <<= 1) { const int v = __builtin_amdgcn_ds_bpermute((lane + o) << 2, suf); if (lane + o < 64) suf += v; }
    const int above = suf - ls;
    const bool mine = (above < kk) && (suf >= kk);
    const unsigned long long bal = __ballot(mine); const int src = __ffsll((long long)bal) - 1;
    int bsel = 0, krem = kk;
    { int acc = above; if (acc + (int)c3 >= kk) { bsel = 3; krem = kk - acc; } else { acc += (int)c3; if (acc + (int)c2 >= kk) { bsel = 2; krem = kk - acc; } else { acc += (int)c2;
          if (acc + (int)c1 >= kk) { bsel = 1; krem = kk - acc; } else { acc += (int)c1; bsel = 0; krem = kk - acc; } } } }
    bsel_out = __builtin_amdgcn_readlane(bsel + 4 * lane, src); krem_out = __builtin_amdgcn_readlane(krem, src);
}
__device__ __forceinline__ void select_row16(const LAS unsigned short* sc, const LAS unsigned* hist0, LAS unsigned* hist1, int t, int row, unsigned long long* MASK, int lane) {
    typedef unsigned u32x4_t __attribute__((ext_vector_type(4)));
    unsigned traw = 0xFC00u;
    if (t + 1 > 256) {
        int b0, k1; hist_pick(hist0, 256, lane, b0, k1);
        const bool pos = b0 >= 128; const unsigned rawhi = pos ? (unsigned)(b0 & 127) : (unsigned)(~b0 & 255);
        hist1[lane] = 0u; hist1[64 + lane] = 0u; hist1[128 + lane] = 0u; hist1[192 + lane] = 0u;
        LDS_WAIT(); asm volatile("" ::: "memory");
        const int ng = (t >> 9) + 1;
        const LAS u32x4_t* sc8 = (const LAS u32x4_t*)sc + lane;
#pragma unroll 2
        for (int g = 0; g < ng; ++g) { const u32x4_t v = sc8[64 * g]; const int s0 = 512 * g + 8 * lane;
#define SEL_P1(word, sh, sx) do { const unsigned x_ = ((word) >> (sh)) & 0xFFFFu; if ((x_ >> 8) == rawhi && (sx) <= t) \
            __hip_atomic_fetch_add(hist1 + (pos ? (x_ & 255u) : (~x_ & 255u)), 1u, __ATOMIC_RELAXED, __HIP_MEMORY_SCOPE_WORKGROUP); } while (0)
            SEL_P1(v.x, 0, s0); SEL_P1(v.x, 16, s0 + 1); SEL_P1(v.y, 0, s0 + 2); SEL_P1(v.y, 16, s0 + 3); SEL_P1(v.z, 0, s0 + 4); SEL_P1(v.z, 16, s0 + 5); SEL_P1(v.w, 0, s0 + 6); SEL_P1(v.w, 16, s0 + 7);
#undef SEL_P1
        }
        LDS_WAIT(); asm volatile("" ::: "memory");
        int b1, k2; hist_pick(hist1, k1, lane, b1, k2);
        traw = pos ? (((unsigned)(b0 & 127) << 8) | (unsigned)b1) : ((~(((unsigned)b0 << 8) | (unsigned)b1)) & 0xFFFFu);
    }
    const _Float16 T = __builtin_bit_cast(_Float16, (unsigned short)traw);
    const int nj = (t >> 6) + 1;
    unsigned long long myword = 0ull;
#pragma unroll 4
    for (int jj = 0; jj < nj; ++jj) { const int s = jj * 64 + lane; const _Float16 x = __builtin_bit_cast(_Float16, sc[s]);
        const unsigned long long word = __ballot(s <= t && x >= T);
        if (lane == jj) myword = word; }
    *(GAS unsigned long long*)(MASK + (size_t)row * 64 + lane) = myword;
}
__device__ __forceinline__ float relu1(float x) { const int i = __builtin_bit_cast(int, x); return __builtin_bit_cast(float, i > 0 ? i : 0); }
#define IDX_WAITBAR(N) asm volatile("s_waitcnt vmcnt(" #N ") lgkmcnt(0)\n\ts_barrier" ::: "memory")
constexpr int IDX_RING_OFF = 65536, IDX_SLOT = 16384;
typedef short idx_bf16x8_t __attribute__((ext_vector_type(8)));
struct IdxPre { idx_bf16x8_t aq[4][4]; idx_bf16x8_t P0[4], P1[4]; f32x4 w; };
__device__ __forceinline__ void idx_prefetch(const Frame& F, int b, int t0, IdxPre& R) {
    const int lane = F.lane, wid = F.wave, n32 = lane & 31, hi = lane >> 5;
    const bf16* QI = (const bf16*)(F.ws + WS_QI); const bf16* KIB = (const bf16*)(F.ws + WS_KIB); const float* WI = (const float*)(F.ws + WS_WI);
    const size_t rowb = (size_t)b * SEQ;
#pragma unroll
    for (int m = 0; m < 4; ++m) { const bf16* qrow = QI + (rowb + t0 + 2 * m + ((n32 >> 2) & 1)) * D + ((n32 & 3) + 4 * (n32 >> 3)) * HD + 8 * hi;
#pragma unroll
        for (int ks = 0; ks < 4; ++ks) R.aq[m][ks] = *(const GAS idx_bf16x8_t*)(qrow + 16 * ks); }
    R.w = (f32x4){0.f, 0.f, 0.f, 0.f};
    if (F.tid < 32) R.w = *(const GAS f32x4*)(WI + (rowb + t0) * 16 + 4 * F.tid);
    const int nb = (t0 + 8 + 31) >> 5, nj = (nb - wid + 7) >> 3;
    const bf16* kp = KIB + rowb * 64 + wid * 2048 + hi * 256 + n32 * 8;
#pragma unroll
    for (int ks = 0; ks < 4; ++ks) { R.P0[ks] = (idx_bf16x8_t){}; R.P1[ks] = (idx_bf16x8_t){}; }
    if (nj > 0) {
#pragma unroll
        for (int ks = 0; ks < 4; ++ks) R.P0[ks] = *(const GAS idx_bf16x8_t*)(kp + 512 * ks); }
    if (nj > 1) {
#pragma unroll
        for (int ks = 0; ks < 4; ++ks) R.P1[ks] = *(const GAS idx_bf16x8_t*)(kp + (size_t)(256 * 64) + 512 * ks); }
}
__device__ __forceinline__ void indexer_unit8(Frame& F, int b, int t0, int nb_, int nt0, IdxPre& R, const int probe_skip = 0) {
    typedef idx_bf16x8_t bf16x8_t; typedef float f32x16_t __attribute__((ext_vector_type(16)));
    const int lane = F.lane, wid = F.wave, n32 = lane & 31, hi = lane >> 5;
    const bf16* KIB = (const bf16*)(F.ws + WS_KIB);
    unsigned long long* MASK = (unsigned long long*)(F.ws + WS_MASK);
    LAS unsigned short* scores = (LAS unsigned short*)(F.lds + RING_OFF);
    const size_t rowb = (size_t)b * SEQ;
    LAS f32x4* wl = (LAS f32x4*)(F.lds + RING_OFF + IDX_RING_OFF + 8192);
    if (F.tid < 32) wl[F.tid] = R.w;
    const int tokh = t0 + hi;
    const int nb = (probe_skip & 16) ? 1 : ((t0 + 8 + 31) >> 5);
    LAS unsigned* hist0 = (LAS unsigned*)(F.lds + AUX_OFF);
    LAS unsigned* myhist = hist0 + hi * 256;
#pragma unroll
    for (int i = 0; i < 4; ++i) hist0[i * 512 + wid * 64 + lane] = 0u;
    asm volatile("s_waitcnt lgkmcnt(0)\n\ts_barrier" ::: "memory");
    const bf16* kp = KIB + (rowb + 32 * wid + n32) * 64 + 8 * hi;
    LAS unsigned short* myrow = scores + hi * 4096 + 32 * wid + n32;
#define IDX_LOADB(dst, blk) do { const bf16* p_ = kp + (size_t)(blk) * (256 * 64); _Pragma("unroll") for (int ks = 0; ks < 4; ++ks) dst[ks] = *(const GAS bf16x8_t*)(p_ + 16 * ks); } while (0)
#define IDX_BLOCK(bf, blk) do { \
        f32x16_t c[4] = {}; \
        _Pragma("unroll") for (int ks = 0; ks < 4; ++ks) _Pragma("unroll") for (int m = 0; m < 4; ++m) c[m] = __builtin_amdgcn_mfma_f32_32x32x16_bf16(R.aq[m][ks], bf[ks], c[m], 0, 0, 0); \
        const int kpos = (wid + 8 * (blk)) * 32 + n32; \
        _Pragma("unroll") for (int m = 0; m < 4; ++m) { \
            const LAS f32x4* wp_ = wl + (2 * m + hi) * 4; const f32x4 wv_[4] = {wp_[0], wp_[1], wp_[2], wp_[3]}; \
            float sa = 0.f, sb = 0.f; \
            _Pragma("unroll") for (int r = 0; r < 16; r += 2) { sa += relu1(c[m][r]) * wv_[r >> 2][r & 3]; sb += relu1(c[m][r + 1]) * wv_[(r + 1) >> 2][(r + 1) & 3]; } \
            const bool ok = kpos <= tokh + 2 * m; \
            const _Float16 hv = (_Float16)(ok ? (sa + sb) : -INFINITY); \
            const unsigned hb = __builtin_bit_cast(unsigned short, hv); \
            myrow[m * 8192 + (blk) * 256] = (unsigned short)hb; \
            if (ok) __hip_atomic_fetch_add(myhist + m * 512 + ((hb & 0x8000u) ? ((~hb >> 8) & 255u) : ((hb >> 8) | 128u)), 1u, __ATOMIC_RELAXED, __HIP_MEMORY_SCOPE_WORKGROUP); \
        } } while (0)
    const int nj = (nb - wid + 7) >> 3;
    bf16x8_t P0[4], P1[4];
#pragma unroll
    for (int ks = 0; ks < 4; ++ks) { P0[ks] = R.P0[ks]; P1[ks] = R.P1[ks]; }
#pragma unroll 1
    for (int jb = 0; jb < nj; jb += 2) {
        bf16x8_t T0[4], T1[4];
        if (jb + 2 < nj) IDX_LOADB(T0, jb + 2);
        IDX_BLOCK(P0, jb);
        if (jb + 1 < nj) {
            if (jb + 3 < nj) IDX_LOADB(T1, jb + 3);
            IDX_BLOCK(P1, jb + 1);
        }
#pragma unroll
        for (int ks = 0; ks < 4; ++ks) { P0[ks] = T0[ks]; P1[ks] = T1[ks]; }
    }
#undef IDX_LOADB
#undef IDX_BLOCK
    IdxPre RN;
    idx_prefetch(F, nt0 >= 0 ? nb_ : b, nt0 >= 0 ? nt0 : t0, RN);
    asm volatile("s_waitcnt lgkmcnt(0)\n\ts_barrier" ::: "memory");
    int lane_s = lane; asm volatile("" : "+v"(lane_s));
    if (!(probe_skip & 1)) select_row16(scores + wid * 4096, hist0 + wid * 256, (LAS unsigned*)(F.lds + RING_OFF + IDX_RING_OFF + wid * 1024), t0 + wid, (int)(rowb + t0 + wid), MASK, lane_s);
    asm volatile("s_waitcnt lgkmcnt(0)\n\ts_barrier" ::: "memory");
#pragma unroll
    for (int m = 0; m < 4; ++m)
#pragma unroll
        for (int ks = 0; ks < 4; ++ks) R.aq[m][ks] = RN.aq[m][ks];
#pragma unroll
    for (int ks = 0; ks < 4; ++ks) { R.P0[ks] = RN.P0[ks]; R.P1[ks] = RN.P1[ks]; }
    R.w = RN.w;
}
__device__ __forceinline__ void indexer_phase16(Frame& F, const int probe_skip = 0) {
    IdxPre R;
    if (F.G == 256) { const int b = F.vcu >> 6, s = F.vcu & 63;
        idx_prefetch(F, b, 8 * s, R);
#pragma unroll 1
        for (int i = 0; i < 8; ++i) { const int oc = (i >> 1) * 128 + ((i & 1) ? 127 - s : s); const int j = i + 1, ocn = (j >> 1) * 128 + ((j & 1) ? 127 - s : s);
            indexer_unit8(F, b, 8 * oc, b, i < 7 ? 8 * ocn : -1, R, probe_skip); }
    } else {
        if (F.vcu < 2048) idx_prefetch(F, F.vcu >> 9, 8 * (F.vcu & 511), R);
#pragma unroll 1
        for (int u = F.vcu; u < 2048; u += F.G) { const int un = u + F.G; indexer_unit8(F, u >> 9, 8 * (u & 511), un >> 9, un < 2048 ? 8 * (un & 511) : -1, R, probe_skip); }
    }
}
constexpr int IDXS_H0 = 0, IDXS_H1 = 16384, IDXS_WL = 24576;
static_assert(IDXS_WL + 1024 <= AUX_BYTES, "indexer LDS");
__device__ __forceinline__ bool idx_unit_at(const Frame& F, int i, int& b, int& t0) {
    if (F.G == 256) { if (i >= 8) return false; const int s = F.vcu & 63; b = F.vcu >> 6; t0 = 8 * ((i >> 1) * 128 + ((i & 1) ? 127 - s : s)); return true; }
    const int u = F.vcu + i * F.G; if (u >= 2048) return false; b = u >> 9; t0 = 8 * (u & 511); return true;
}
#ifndef IDX_ABL_K2
#define IDX_ABL_K2 0
#endif
template <int probe> __device__ __forceinline__ void idx_keys(const Frame& F, int b, int t0, IdxPre& R, LAS unsigned short* scores, LAS unsigned* hist0, const LAS f32x4* wl) {
    typedef idx_bf16x8_t bf16x8_t; typedef float f32x16_t __attribute__((ext_vector_type(16))); typedef _Float16 h2_t __attribute__((ext_vector_type(2)));
    const int lane = F.lane, wid = F.wave, n32 = lane & 31, hi = lane >> 5;
    const bf16* KIB = (const bf16*)(F.ws + WS_KIB);
    const size_t rowb = (size_t)b * SEQ;
    const int tokh = t0 + hi;
    const int nb = (t0 + 8 + 31) >> 5;
    LAS unsigned* myhist = hist0 + hi * 256;
    const bf16* kp = KIB + rowb * 64 + wid * 2048 + hi * 256 + n32 * 8;
    LAS unsigned short* myrow = scores + hi * 4096 + 32 * wid + n32;
    const int nj = (nb - wid + 7) >> 3, njm = nj > 0 ? nj - 1 : 0;
    h2_t wv[4][8];
#pragma unroll
    for (int m = 0; m < 4; ++m)
#pragma unroll
        for (int jq = 0; jq < 4; ++jq) { const f32x4 t = wl[(2 * m + hi) * 4 + jq]; wv[m][2 * jq] = (h2_t){(_Float16)t.x, (_Float16)t.y}; wv[m][2 * jq + 1] = (h2_t){(_Float16)t.z, (_Float16)t.w}; }
#define IDX_LOADB(dst, blk) do { const int bc_ = (blk) < njm ? (blk) : njm; const bf16* p_ = kp + (size_t)bc_ * (256 * 64); _Pragma("unroll") for (int ks = 0; ks < 4; ++ks) dst[ks] = *(const GAS bf16x8_t*)(p_ + 512 * ks); } while (0)
#define IDX_MMA(cd, bf, h) do { cd[0] = (f32x16_t){}; cd[1] = (f32x16_t){}; \
        _Pragma("unroll") for (int ks = 0; ks < 4; ++ks) _Pragma("unroll") for (int mm = 0; mm < 2; ++mm) cd[mm] = __builtin_amdgcn_mfma_f32_32x32x16_bf16(R.aq[2 * (h) + mm][ks], bf[ks], cd[mm], 0, 0, 0); } while (0)
#define IDX_EPI(cs, blk, h) do { const int kpos = (wid + 8 * (blk)) * 32 + n32; \
        _Pragma("unroll") for (int mm = 0; mm < 2; ++mm) { const int m = 2 * (h) + mm; \
            float sa = 0.f, sb = 0.f; \
            _Pragma("unroll") for (int r = 0; r < 16; r += 4) { \
                const h2_t p0_ = __builtin_elementwise_max(__builtin_bit_cast(h2_t, __builtin_amdgcn_cvt_pkrtz(cs[mm][r], cs[mm][r + 1])), (h2_t){(_Float16)0, (_Float16)0}); \
                const h2_t p1_ = __builtin_elementwise_max(__builtin_bit_cast(h2_t, __builtin_amdgcn_cvt_pkrtz(cs[mm][r + 2], cs[mm][r + 3])), (h2_t){(_Float16)0, (_Float16)0}); \
                sa = __builtin_amdgcn_fdot2(p0_, wv[m][r >> 1], sa, false); sb = __builtin_amdgcn_fdot2(p1_, wv[m][(r >> 1) + 1], sb, false); } \
            const bool ok = kpos <= tokh + 2 * m; \
            const _Float16 hv = (_Float16)(ok ? (sa + sb) : -INFINITY); \
            const unsigned hb = __builtin_bit_cast(unsigned short, hv); \
            myrow[m * 8192 + (blk) * 256] = (unsigned short)hb; \
            const unsigned key_ = hb ^ ((unsigned)__builtin_amdgcn_sbfe((int)hb, 15, 1) | 0x8000u);        \
            if (!(probe & 1)) __hip_atomic_fetch_add(myhist + m * 512 + __builtin_amdgcn_ubfe(key_, 8, 8), 1u, __ATOMIC_RELAXED, __HIP_MEMORY_SCOPE_WORKGROUP); \
        } } while (0)
#define IDX_ILV() do { _Pragma("unroll") for (int g_ = 0; g_ < 8; ++g_) { __builtin_amdgcn_sched_group_barrier(0x008, 1, 0); __builtin_amdgcn_sched_group_barrier(0x002, 9, 0); } } while (0)
    bf16x8_t P0[4], T0[4];
#pragma unroll
    for (int ks = 0; ks < 4; ++ks) { P0[ks] = R.P0[ks]; T0[ks] = R.P1[ks]; }
    __builtin_amdgcn_s_waitcnt(0x0070);
    if (nj > 0) {
        f32x16_t cA[2], cB[2];
        IDX_MMA(cA, P0, 0);
        const int npair = nj >> 1;
#pragma unroll 1
        for (int jb = 0; jb < 2 * npair; jb += 2) {
            IDX_MMA(cB, P0, 1); IDX_EPI(cA, jb, 0); IDX_ILV();
            IDX_LOADB(P0, jb + 2);
            IDX_MMA(cA, T0, 0); IDX_EPI(cB, jb, 1); IDX_ILV();
            IDX_MMA(cB, T0, 1); IDX_EPI(cA, jb + 1, 0); IDX_ILV();
            IDX_LOADB(T0, jb + 3);
            IDX_MMA(cA, P0, 0); IDX_EPI(cB, jb + 1, 1); IDX_ILV();
        }
        if (nj & 1) { const int jb = 2 * npair; IDX_MMA(cB, P0, 1); IDX_EPI(cA, jb, 0); IDX_EPI(cB, jb, 1); }
    }
#undef IDX_LOADB
#undef IDX_MMA
#undef IDX_EPI
#undef IDX_ILV
}
template <int probe> __device__ __forceinline__ void indexer_phase_stag(Frame& F) {
    const int wid = F.wave;
    const bool grpB = wid >= 4;
    LAS unsigned short* sc = (LAS unsigned short*)(F.lds + RING_OFF);
    LAS unsigned* h0 = (LAS unsigned*)(F.lds + AUX_OFF + IDXS_H0);
    LAS unsigned* h1 = (LAS unsigned*)(F.lds + AUX_OFF + IDXS_H1) + wid * 256;
    LAS f32x4* wl = (LAS f32x4*)(F.lds + AUX_OFF + IDXS_WL);
    unsigned long long* MASK = (unsigned long long*)(F.ws + WS_MASK);
    int cb = 0, ct0 = 0;
    if (!idx_unit_at(F, 0, cb, ct0)) return;
    IdxPre R; idx_prefetch(F, cb, ct0, R);
#pragma unroll
    for (int i = 0; i < 8; ++i) h0[i * 512 + F.tid] = 0u;
    if (F.tid < 32) wl[F.tid] = R.w;
    asm volatile("s_waitcnt lgkmcnt(0)\n\ts_barrier" ::: "memory");
    bool hasK = true, hasS = false; int pb = 0, pt0 = 0;
#pragma unroll 1
    for (int s = 0; hasK || hasS; ++s) {
        const int p = s & 1;
        int nb_ = cb, nt0 = ct0; bool hasN = false;
#pragma unroll 1
        for (int half = 0; half < 2; ++half) {
            if ((half == 0) == grpB) {
                if (hasS && !(probe & 2)) { int lane_s = F.lane; asm volatile("" : "+v"(lane_s));
                    select_row16(sc + (p ^ 1) * 32768 + wid * 4096, h0 + (p ^ 1) * 2048 + wid * 256, h1, pt0 + wid, pb * SEQ + pt0 + wid, MASK, lane_s); }
            } else if (hasK) {
                idx_keys<probe>(F, cb, ct0, R, sc + p * 32768, h0 + p * 2048, wl + p * 32);
                if (IDX_ABL_K2) idx_keys<1>(F, cb, ct0, R, sc + p * 32768, h0 + p * 2048, wl + p * 32);
                hasN = idx_unit_at(F, s + 1, nb_, nt0);
                idx_prefetch(F, nb_, nt0, R);
            }
        }
        { LAS unsigned* hz = h0 + (p ^ 1) * 2048 + wid * 256 + F.lane;
            hz[0] = 0u; hz[64] = 0u; hz[128] = 0u; hz[192] = 0u; }
        if (hasN && F.tid < 32) wl[(p ^ 1) * 32 + F.tid] = R.w;
        asm volatile("s_waitcnt lgkmcnt(0)\n\ts_barrier" ::: "memory");
        pb = cb; pt0 = ct0; hasS = hasK; cb = nb_; ct0 = nt0; hasK = hasN;
    }
}

template <int MODE> __device__ __forceinline__ void attn_phase(Frame& F, const Args& A, bool dry = false) {
    using attn_body::bf16;
    bf16* Q = (bf16*)(F.ws + WS_Q); bf16* O = dry ? (bf16*)(F.ws + WS_END) : Q; const bf16* K = (const bf16*)(F.ws + WS_K); const bf16* V = (const bf16*)(F.ws + WS_V);
    const float* rb = A.in[5]; const float* KM = (const float*)(F.ws + WS_KM); const unsigned* MASK32 = (const unsigned*)(F.ws + WS_MASK);
    char* shm = (char*)F.lds + RING_OFF;
    static_assert(attn_body::ATTN_LDS_BYTES <= RING_BYTES, "attention scratch fits the ring region");
    if (MODE == 2) {
        if (F.G == 256) { const int bh = F.vcu >> 2, s = F.vcu & 3;
#pragma unroll 1
            for (int i = 0; i < 4; ++i) { const int qb = i == 0 ? s : (i == 1 ? 7 - s : (i == 2 ? 8 + s : 15 - s)); attn_body::attn_unit<MODE, 8>(bh >> 4, bh & 15, qb, Q, K, V, O, shm, F.wave, rb, KM, MASK32, i == 0); }
        } else {
#pragma unroll 1
            for (int u = F.vcu; u < 1024; u += F.G) attn_body::attn_unit<MODE, 8>(u >> 8, (u >> 4) & 15, u & 15, Q, K, V, O, shm, F.wave, rb, KM, MASK32, true);
        }
    } else {
        const int hoff = MODE == 1 ? 8 : 0;
        if (F.G == 256) { const int bh = F.vcu >> 3, s = F.vcu & 7;
#pragma unroll 1
            for (int i = 0; i < 2; ++i) { const int qb = i == 0 ? s : 15 - s; attn_body::attn_unit<MODE, 8>(bh >> 3, hoff + (bh & 7), qb, Q, K, V, O, shm, F.wave, rb, KM, MASK32, i == 0); }
        } else {
#pragma unroll 1
            for (int u = F.vcu; u < 512; u += F.G) attn_body::attn_unit<MODE, 8>(u >> 7, hoff + ((u >> 4) & 7), u & 15, Q, K, V, O, shm, F.wave, rb, KM, MASK32, true);
        }
    }
}

__global__ void __launch_bounds__(NWAVES * 64, 2) mk_fwd(Args args) {
    extern __shared__ __attribute__((aligned(16))) unsigned char lds[];
    Frame F;
    F.lds = (LAS unsigned char*)lds;
    F.MISC = (volatile LAS unsigned*)(F.lds + MISC_OFF);
    F.wave = __builtin_amdgcn_readfirstlane(threadIdx.x >> 6); F.lane = hw_lane(); F.tid = F.wave * 64 + F.lane;
    F.G = gridDim.x; { const int bx = blockIdx.x; F.vcu = (F.G % 8 == 0) ? (bx % 8) * (F.G / 8) + bx / 8 : bx; }
    F.out = args.out; F.ws = args.ws;
    for (int u = F.tid; u < (LDS_BYTES - LDSCTL_OFF) / 4; u += NWAVES * 64) ((LAS unsigned*)(F.lds + LDSCTL_OFF))[u] = 0u;
    __syncthreads();
    XcdBarrier bar = xcd_barrier_post((unsigned*)(F.ws + WS_BAR), F.MISC + 8, F.wave);
#define GRID_BAR() do { REP(8) xcd_barrier(bar); } while (0)
#define FILL_RSTD(SSIN) \
            { pg8::Unit u_; PG8_LAS float* rt_ = (PG8_LAS float*)(F.lds + AUX_OFF + 2048);       \
              for (int i_ = 0; i_ < 6 && S.next(i_, u_); ++i_) if (F.tid < 256) rt_[i_ * 256 + F.tid] = pg8::row_rstd(SSIN, u_.pm * 256 + F.tid); __syncthreads(); }
#define PHASE_PTRS() RELAUNDER(F); unsigned char* ws = F.ws; \
    pg8::bf16_t* XB = (pg8::bf16_t*)(ws + WS_XB); pg8::bf16_t* Qb = (pg8::bf16_t*)(ws + WS_Q); pg8::bf16_t* Kb = (pg8::bf16_t*)(ws + WS_K); pg8::bf16_t* Vb = (pg8::bf16_t*)(ws + WS_V); \
    pg8::bf16_t* QIb = (pg8::bf16_t*)(ws + WS_QI); pg8::bf16_t* KIBb = (pg8::bf16_t*)(ws + WS_KIB); pg8::bf16_t* Gb = (pg8::bf16_t*)(ws + WS_G); float* SS = (float*)(ws + WS_SS); \
    (void)XB; (void)Qb; (void)Kb; (void)Vb; (void)QIb; (void)KIBb; (void)Gb; (void)SS

    p0_prologue(F, args); GRID_BAR();

#pragma unroll 1
    for (int L = 0; L < DEPTH; ++L) {
        const bool even = !(L & 1); const int j = L >> 1;
        {
            PHASE_PTRS();
            const int N = even ? NIN_E : NIN_O;
            pg8::Gemm g{XB, (const pg8::bf16_t*)(ws + WS_WIN), M, N, D}; pg8::StaticOrder S; S.init(M, N, F.G, (int)blockIdx.x);
            pg8::EpiIn E{Qb, Kb, Vb, QIb, KIBb, (float*)(ws + WS_WI), (float*)(ws + WS_KM), (const PG8_LAS float*)(F.lds + AUX_OFF + 2048), even ? 1 : 0, (PG8_LAS float*)(F.lds + AUX_OFF), SS + (size_t)M * 4};
#if (PROBE_DUP & 64)
            { pg8::EpiInT<true> E2{E.Q, E.K, E.V, E.QI, E.KIB, E.WI, E.KM, E.rtab, E.even, E.ex, E.ssin}; pg8::gemm_phase<pg8::EpiInT<true>, pg8::StaticOrder, true, true>(F.lds + RING_OFF, g, S, E2, F.wave); }
#endif
            REP(1) pg8::gemm_phase<pg8::EpiIn, pg8::StaticOrder, true, true>(F.lds + RING_OFF, g, S, E, F.wave);
        }
        if (L == 0) {
            RELAUNDER(F);
            const int nun = (M / 256) * (NIN_E / 256), full = nun / F.G, rem = nun - full * F.G;
            if (rem > 0 && rem < F.G) { if ((int)blockIdx.x >= rem) convert_layer(F, args, 0, ((int)blockIdx.x - rem) * NWAVES + F.wave, (F.G - rem) * NWAVES, 14); }
            else convert_layer(F, args, 0, F.vcu * NWAVES + F.wave, F.G * NWAVES, 14);
        }
        GRID_BAR();
        RELAUNDER(F);
#if defined(MK_SIMPLE_ATTN)
        if (even) { simple_indexer(F, j); RELAUNDER(F); simple_moba(F, args, j); GRID_BAR(); RELAUNDER(F); simple_dsa(F, args); }
        else simple_dilated(F, args);
#else
        if (even) { REP(4) { if ((PROBE_DUP & 0x700) && rep_ == 0) indexer_phase_stag<(PROBE_DUP >> 8) & 7>(F); else indexer_phase_stag<0>(F); } RELAUNDER(F); REP(2 | 256) attn_phase<0>(F, args, (PROBE_DUP & (2 | 256)) && rep_ == 0); GRID_BAR(); RELAUNDER(F); REP(2 | 512) attn_phase<1>(F, args, (PROBE_DUP & (2 | 512)) && rep_ == 0); }
        else REP(2 | 128) attn_phase<2>(F, args, (PROBE_DUP & (2 | 128)) && rep_ == 0);
#endif
        GRID_BAR();
        {
            PHASE_PTRS();
            pg8::Gemm g{Qb, (const pg8::bf16_t*)(ws + WS_WO), M, D, D}; pg8::StaticOrder S; S.init(M, D, F.G, (int)blockIdx.x);
            pg8::EpiRes E{XB, SS, (PG8_LAS float*)(F.lds + AUX_OFF)};
            pg8::gemm_phase<pg8::EpiRes, pg8::StaticOrder, true, true>(F.lds + RING_OFF, g, S, E, F.wave);
        }
        GRID_BAR();
        {
            PHASE_PTRS();
            pg8::Gemm g{XB, (const pg8::bf16_t*)(ws + ((L & 1) ? WS_WUP2 : WS_WUP)), M, NUP, D}; pg8::StaticOrder S; S.init(M, NUP, F.G, (int)blockIdx.x);
            pg8::EpiUp E{Gb, (float*)(ws + WS_UE), (const PG8_LAS float*)(F.lds + AUX_OFF + 2048), (const float*)(ws + WS_CW) + (size_t)L * 4 * NUP, (const float*)(ws + WS_CW) + (size_t)L * 4 * NUP + 3 * NUP, (PG8_LAS float*)(F.lds + AUX_OFF), SS};
#if (PROBE_DUP & 64)
            { pg8::EpiUpT<true> E2{E.G, E.UE, E.rtab, E.cw, E.cb, E.ex, E.ssin}; pg8::gemm_phase<pg8::EpiUpT<true>, pg8::StaticOrder, true, true>(F.lds + RING_OFF, g, S, E2, F.wave); }
#endif
            REP(1) pg8::gemm_phase<pg8::EpiUp, pg8::StaticOrder, true, true>(F.lds + RING_OFF, g, S, E, F.wave);
        }
        if (L + 1 < DEPTH) {
            RELAUNDER(F);
            const int nun = (M / 256) * (NUP / 256), full = nun / F.G, rem = nun - full * F.G;
            if (rem > 0 && rem < F.G) { if ((int)blockIdx.x >= rem) REP(16) convert_layer(F, args, L + 1, ((int)blockIdx.x - rem) * NWAVES + F.wave, (F.G - rem) * NWAVES); }
            else REP(16) convert_layer(F, args, L + 1, F.vcu * NWAVES + F.wave, F.G * NWAVES);
        }
        GRID_BAR();
        {
            PHASE_PTRS();
            pg8::StaticOrder S; S.init(M, D, F.G, (int)blockIdx.x);
            { pg8::Unit u; for (int i = 0; S.next(i, u); ++i) if (u.pm & 15) fix_rows(F, args, u.pm, L); }
            VM_WAIT(); __syncthreads();
            pg8::Gemm g{Gb, (const pg8::bf16_t*)(ws + WS_WDN) + (size_t)(L & 1) * D * FF, M, D, FF};
            pg8::EpiRes E{XB, SS + (size_t)M * 4, (PG8_LAS float*)(F.lds + AUX_OFF)};
            pg8::gemm_phase<pg8::EpiRes, pg8::StaticOrder, true, true>(F.lds + RING_OFF, g, S, E, F.wave);
        }
        GRID_BAR();
    }
    RELAUNDER(F);
    final_norm(F, args);
#undef GRID_BAR
#undef FILL_RSTD
#undef PHASE_PTRS
}

extern "C" void kernel_launch(void* const* d_in, const int* in_sizes, int n_in, void* d_out, int out_size, void* d_ws, size_t ws_size, hipStream_t stream) {
    static int grid = 0;
    if (grid == 0) {
        if (n_in != 13 || in_sizes[0] != M * D || out_size != M * D || ws_size < WS_END) { fprintf(stderr, "kernel_launch: unexpected problem (n_in %d, in0 %d, out %d, ws %zu)\n", n_in, n_in > 0 ? in_sizes[0] : -1, out_size, ws_size); grid = -1; return; }
        int dev = 0, cus = 0, per_cu = 0;
        if (hipGetDevice(&dev) != hipSuccess || hipDeviceGetAttribute(&cus, hipDeviceAttributeMultiprocessorCount, dev) != hipSuccess) { grid = -1; return; }
        if (hipFuncSetAttribute((const void*)mk_fwd, hipFuncAttributeMaxDynamicSharedMemorySize, LDS_BYTES) != hipSuccess) { fprintf(stderr, "kernel_launch: hipFuncSetAttribute failed\n"); grid = -1; return; }
        if (hipOccupancyMaxActiveBlocksPerMultiprocessor(&per_cu, (const void*)mk_fwd, NWAVES * 64, LDS_BYTES) != hipSuccess || per_cu < 1) { fprintf(stderr, "kernel_launch: occupancy query says %d blocks per CU\n", per_cu); grid = -1; (void)hipGetLastError(); return; }
        grid = cus;
    }
    if (grid < 0) return;
    if (hipMemsetAsync((char*)d_ws + WS_BAR, 0, BAR_ZERO_BYTES, stream) != hipSuccess) return;
    Args a{};
    for (int i = 0; i < 13; ++i) a.in[i] = (const float*)d_in[i];
    a.out = (float*)d_out; a.ws = (unsigned char*)d_ws;
    hipLaunchKernelGGL(mk_fwd, dim3(grid), dim3(NWAVES * 64), LDS_BYTES, stream, a);
}
```

```cpp
#include <hip/hip_runtime.h>
#include <hip/hip_bf16.h>
#include <cstdio>
#include <cstdint>
#include <cmath>

constexpr int BATCH = 4, SEQ = 4096, M = BATCH * SEQ, D = 1024, NH = 16, HD = 64, FF = 2816, NUP = 2 * FF, DEPTH = 4;
constexpr int EVEN_IN = 4176, NIN_E = 4352  , NIN_O = 3072;
constexpr float RMS_EPS = 1e-6f;
constexpr float LOG2E = 1.4426950408889634f;
constexpr float C2 = 0.125f * LOG2E;

#ifndef PROBE_DUP
#define PROBE_DUP 0
#endif
#define REP(mask) for (int rep_ = 0; rep_ < ((PROBE_DUP & (mask)) ? 2 : 1); ++rep_)
namespace pg8 {
#define PG8_LAS __attribute__((address_space(3)))
typedef unsigned short bf16_t;
typedef short bf16x8 __attribute__((ext_vector_type(8)));
typedef float f32x4 __attribute__((ext_vector_type(4)));
typedef unsigned u32x4 __attribute__((ext_vector_type(4)));
constexpr int BM = 256, BK = 64, HALF = 128, HTB = HALF * BK * 2  , STAGE_BYTES = 8 * HTB, NXCD = 8, WGM = 8;

__host__ __device__ __forceinline__ int lds_byte(int r, int c) { const int st = (r >> 4) * 2 + (c >> 5), rr = r & 15, cc = c & 31, ob = rr * 64 + cc * 2; return st * 1024 + (ob ^ (((ob >> 9) & 1) << 5)); }
__host__ __device__ __forceinline__ void stage_rc(int b, int& R, int& C) { const int st = b / 1024, sb = b % 1024, swz = sb ^ (((sb >> 9) & 1) << 5); R = (st >> 1) * 16 + swz / 64; C = (st & 1) * 32 + (swz % 64) / 2; }
__host__ __device__ __forceinline__ int perm32(int rho) { const int n = rho >> 4, i = rho & 15; return 8 * (i >> 2) + 4 * n + (i & 3); }

struct Unit { int pm, pn, idx, half; };
struct Gemm { const bf16_t* A; const bf16_t* Bt; int M, N, K; };

struct StaticOrder {
    int nM, nN, nwg, G, c;
    __host__ __device__ __forceinline__ void init(int M, int N, int G_, int c_) { nM = M / BM; nN = N / BM; nwg = nM * nN; G = G_; c = c_; }
    __host__ __device__ __forceinline__ bool next(int i, Unit& u) const {
        const long L = (long)i * G + c; if (L >= nwg) return false;
        int wgid = (int)L; { const int q = nwg / NXCD, r = nwg % NXCD, xcd = wgid % NXCD, off = wgid / NXCD; wgid = (xcd < r ? xcd * (q + 1) : r * (q + 1) + (xcd - r) * q) + off; }
        const int nig = WGM * nN, gid = wgid / nig, fm = gid * WGM, gsz = (nM - fm) < WGM ? (nM - fm) : WGM;
        u.pm = fm + ((wgid % nig) % gsz); u.pn = (wgid % nig) / gsz; u.idx = i; u.half = -1; return true;
    }
    __device__ __forceinline__ void a_ready(const Unit&) const {}
    __device__ __forceinline__ void done(const Unit&) const {}
};
struct TailHalves {
    int c, pn;
    __host__ __device__ __forceinline__ void init(int pn_, int c_) { c = c_; pn = pn_; }
    __host__ __device__ __forceinline__ bool next(int i, Unit& u) const {
        if (i != 0 || c >= 128) return false;
        u.pm = 8 * (c & 7) + ((c >> 3) & 7); u.pn = pn; u.idx = 0; u.half = c >> 6; return true;
    }
    __device__ __forceinline__ void a_ready(const Unit&) const {}
    __device__ __forceinline__ void done(const Unit&) const {}
};

__device__ __forceinline__ unsigned cvt_pk_bf16(float lo, float hi) { unsigned r; asm volatile("v_cvt_pk_bf16_f32 %0, %1, %2" : "=v"(r) : "v"(lo), "v"(hi)); return r; }
typedef float f32x2 __attribute__((ext_vector_type(2)));
template <int CTRL> __device__ __forceinline__ float dpp_mov(float old, float src) {
    return __builtin_bit_cast(float, __builtin_amdgcn_update_dpp(__builtin_bit_cast(int, old), __builtin_bit_cast(int, src), CTRL, 0xF, 0xF, false));
}
__device__ __forceinline__ float shift1(float x, float y) { return dpp_mov<0x111>(dpp_mov<0x121>(0.f, y), x); }
__device__ __forceinline__ float shift2(float x, float y) { return dpp_mov<0x112>(dpp_mov<0x122>(0.f, y), x); }
__device__ __forceinline__ float dot4(const f32x4 a) { return (a[0] * a[0] + a[1] * a[1]) + (a[2] * a[2] + a[3] * a[3]); }
__device__ __forceinline__ float row_rstd(const float* SSP, int row) {
    const f32x4 a = *(const __attribute__((address_space(1))) f32x4*)(SSP + (size_t)row * 4);
    return __builtin_amdgcn_rsqf(((a[0] + a[1]) + (a[2] + a[3])) * (1.0f / 1024.0f) + 1e-6f);
}

__device__ __forceinline__ void st4_wt(const void* p, float v) { asm volatile("global_store_dword %0, %1, off sc0 sc1\n\ts_nop 1" :: "v"(p), "v"(v) : "memory"); }
__device__ __forceinline__ void st16_wt(const void* p, u32x4 v) { asm volatile("global_store_dwordx4 %0, %1, off sc0 sc1\n\ts_nop 1" :: "v"(p), "v"(v) : "memory");   }
struct PreRstd { f32x4 a[6]; int n; };
struct PreNone {};
template <class Sched> __device__ __forceinline__ void rstd_pre_issue(PreRstd& P, const Sched& S, const float* ssin, int tid) {
    Unit u; P.n = 0;
#pragma unroll
    for (int i = 0; i < 6; ++i) { P.a[i] = (f32x4){1.f, 1.f, 1.f, 1.f}; if (S.next(i, u)) { P.n = i + 1; if (tid < 256) P.a[i] = *(const __attribute__((address_space(1))) f32x4*)(ssin + (size_t)(u.pm * 256 + tid) * 4); } }
}
__device__ __forceinline__ void rstd_pre_fill(const PreRstd& P, const PG8_LAS float* rtab, int tid) {
    if (tid < 256) {
#pragma unroll
        for (int i = 0; i < 6; ++i) if (i < P.n) ((PG8_LAS float*)rtab)[i * 256 + tid] = __builtin_amdgcn_rsqf(((P.a[i][0] + P.a[i][1]) + (P.a[i][2] + P.a[i][3])) * (1.0f / 1024.0f) + 1e-6f); }
}
template <bool DRY> struct EpiInT {
    static constexpr bool PERM = true, AFTER_DRAIN = false, AROWS8 = false;
    bf16_t *Q, *K, *V, *QI, *KIB; float *WI, *KM; const PG8_LAS float* rtab; int even; PG8_LAS float* ex; const float* ssin;
    typedef PreRstd Pre;
    template <class Sched> __device__ __forceinline__ void pre_issue(Pre& P, const Sched& S, int tid) const { rstd_pre_issue(P, S, ssin, tid); }
    __device__ __forceinline__ void pre_fill(const Pre& P, int tid) const { rstd_pre_fill(P, rtab, tid); }
    __device__ __forceinline__ void operator()(const f32x4 (&acc)[2][2][4][2], const Unit& u, int wr, int wc, int fr_, int fq_) const {
        int fr = fr_, fq = fq_; asm volatile("" : "+v"(fr), "+v"(fq));
        if (DRY) {
#pragma unroll
            for (int ai = 0; ai < 2; ++ai)
#pragma unroll
                for (int bj = 0; bj < 2; ++bj)
#pragma unroll
                    for (int m = 0; m < 4; ++m) asm volatile("" :: "v"(acc[ai][bj][m][0]), "v"(acc[ai][bj][m][1]));
            return; }
        const int row0 = u.pm * BM + wr * 64 + fr;
        float rs[2][4];
#pragma unroll
        for (int ai = 0; ai < 2; ++ai)
#pragma unroll
            for (int m = 0; m < 4; ++m) rs[ai][m] = rtab[u.idx * 256 + ai * HALF + wr * 64 + m * 16 + fr];
        if (u.pn < 16) {
            const int t = u.pn >> 2, colt = (u.pn & 3) * BM;
            bf16_t* base = t == 0 ? Q : (t == 1 ? K : (t == 2 ? V : QI));
            const float sc = t == 0 ? C2 : 1.f;
            const int col0 = colt + wc * 32 + 8 * fq;
#pragma unroll
            for (int ai = 0; ai < 2; ++ai)
#pragma unroll
                for (int m = 0; m < 4; ++m) { const float s = rs[ai][m] * sc; bf16_t* rowp = base + (size_t)(row0 + ai * HALF + m * 16) * 1024 + col0;
#pragma unroll
                    for (int bj = 0; bj < 2; ++bj) { const f32x4 v0 = acc[ai][bj][m][0] * s, v1 = acc[ai][bj][m][1] * s;
                        u32x4 w; w.x = cvt_pk_bf16(v0[0], v0[1]); w.y = cvt_pk_bf16(v0[2], v0[3]); w.z = cvt_pk_bf16(v1[0], v1[1]); w.w = cvt_pk_bf16(v1[2], v1[3]);
                        st16_wt(rowp + bj * HALF, w); } }
            if (even && t == 1 && (u.pn & 3) < 2) {
#pragma unroll
                for (int bj = 0; bj < 2; ++bj)
#pragma unroll
                    for (int n = 0; n < 2; ++n) { f32x4 s = {0.f, 0.f, 0.f, 0.f};
#pragma unroll
                        for (int ai = 0; ai < 2; ++ai)
#pragma unroll
                            for (int m = 0; m < 4; ++m) s += acc[ai][bj][m][n] * rs[ai][m];
#pragma unroll
                        for (int o = 1; o < 16; o <<= 1) { s[0] += __shfl_xor(s[0], o); s[1] += __shfl_xor(s[1], o); s[2] += __shfl_xor(s[2], o); s[3] += __shfl_xor(s[3], o); }
                        if (fr == 0) { const int col = colt + bj * HALF + wc * 32 + 8 * fq + 4 * n, h = col >> 6, d = col & 63;
                            *(__attribute__((address_space(1))) f32x4*)(KM + (((size_t)(((u.pm >> 4) * 8 + h) * 16 + (u.pm & 15))) * 2 + wr) * 64 + d) = s; } }
            }
        } else {
            if (wc < 2) {
#pragma unroll
                for (int ai = 0; ai < 2; ++ai) if (u.half < 0 || u.half == ai)
#pragma unroll
                    for (int m = 0; m < 4; ++m) { const float s = rs[ai][m];
                        const f32x4 v0 = acc[ai][0][m][0] * s, v1 = acc[ai][0][m][1] * s;
                        float q = dot4(v0) + dot4(v1); q += __shfl_xor(q, 16); q += __shfl_xor(q, 32);
                        if (fq == 0) ex[(ai * HALF + wr * 64 + m * 16 + fr) * 2 + wc] = q; }
            }
            asm volatile("s_waitcnt lgkmcnt(0)" ::: "memory"); __builtin_amdgcn_s_barrier(); asm volatile("" ::: "memory");
            if (wc < 2) {
#pragma unroll
                for (int ai = 0; ai < 2; ++ai) if (u.half < 0 || u.half == ai)
#pragma unroll
                    for (int m = 0; m < 4; ++m) { const int rt = ai * HALF + wr * 64 + m * 16 + fr, row = u.pm * BM + rt;
                        const float s = rs[ai][m] * __builtin_amdgcn_rsqf((ex[rt * 2] + ex[rt * 2 + 1]) * (1.0f / 64.0f) + 1e-6f);
                        const f32x4 v0 = acc[ai][0][m][0] * s, v1 = acc[ai][0][m][1] * s;
                        u32x4 w; w.x = cvt_pk_bf16(v0[0], v0[1]); w.y = cvt_pk_bf16(v0[2], v0[3]); w.z = cvt_pk_bf16(v1[0], v1[1]); w.w = cvt_pk_bf16(v1[2], v1[3]);
                        *(__attribute__((address_space(1))) u32x4*)(KIB + (size_t)(row >> 5) * 2048 + (wc * 2 + (fq >> 1)) * 512 + (fq & 1) * 256 + (row & 31) * 8) = w; }
            } else if (wc == 2 && fq < 2) {
#pragma unroll
                for (int ai = 0; ai < 2; ++ai) if (u.half < 0 || u.half == ai)
#pragma unroll
                    for (int m = 0; m < 4; ++m) { const float s = rs[ai][m]; const int row = row0 + ai * HALF + m * 16;
                        *(__attribute__((address_space(1))) f32x4*)(WI + (size_t)row * 16 + 8 * fq) = acc[ai][0][m][0] * s; *(__attribute__((address_space(1))) f32x4*)(WI + (size_t)row * 16 + 8 * fq + 4) = acc[ai][0][m][1] * s; }
            }
        }
    }
};

struct EpiRes {
    static constexpr bool PERM = true, AFTER_DRAIN = false, AROWS8 = false;
    bf16_t* XB; float* SSo; PG8_LAS float* ex;
    typedef PreNone Pre;
    template <class Sched> __device__ __forceinline__ void pre_issue(Pre&, const Sched&, int) const {}
    __device__ __forceinline__ void pre_fill(const Pre&, int) const {}
    __device__ __forceinline__ void operator()(const f32x4 (&acc)[2][2][4][2], const Unit& u, int wr, int wc, int fr_, int fq_) const {
        int fr = fr_, fq = fq_; asm volatile("" : "+v"(fr), "+v"(fq));
        const int row0 = u.pm * BM + wr * 64 + fr, col0 = u.pn * BM + wc * 32 + 8 * fq;
        u32x4 xb[2][4][2];
#pragma unroll
        for (int ai = 0; ai < 2; ++ai)
#pragma unroll
            for (int m = 0; m < 4; ++m)
#pragma unroll
                for (int bj = 0; bj < 2; ++bj) xb[ai][m][bj] = *(const __attribute__((address_space(1))) u32x4*)(XB + (size_t)(row0 + ai * HALF + m * 16) * 1024 + col0 + bj * HALF);
        __builtin_amdgcn_s_waitcnt(0x0F70);
#pragma unroll
        for (int ai = 0; ai < 2; ++ai)
#pragma unroll
            for (int m = 0; m < 4; ++m) { const int row = row0 + ai * HALF + m * 16; const size_t off = (size_t)row * 1024 + col0; float q = 0.f;
#pragma unroll
                for (int bj = 0; bj < 2; ++bj) { const u32x4 b = xb[ai][m][bj];
                    const f32x4 b0 = {__uint_as_float(b.x << 16), __uint_as_float(b.x & 0xffff0000u), __uint_as_float(b.y << 16), __uint_as_float(b.y & 0xffff0000u)};
                    const f32x4 b1 = {__uint_as_float(b.z << 16), __uint_as_float(b.z & 0xffff0000u), __uint_as_float(b.w << 16), __uint_as_float(b.w & 0xffff0000u)};
                    const f32x4 x0 = b0 + acc[ai][bj][m][0], x1 = b1 + acc[ai][bj][m][1];
                    u32x4 w; w.x = cvt_pk_bf16(x0[0], x0[1]); w.y = cvt_pk_bf16(x0[2], x0[3]); w.z = cvt_pk_bf16(x1[0], x1[1]); w.w = cvt_pk_bf16(x1[2], x1[3]);
                    st16_wt(XB + off + bj * HALF, w); q += dot4(x0) + dot4(x1); }
                q += __shfl_xor(q, 16); q += __shfl_xor(q, 32);
                if (fq == 0) ex[(ai * HALF + wr * 64 + m * 16 + fr) * 4 + wc] = q; }
        asm volatile("s_waitcnt lgkmcnt(0)" ::: "memory"); __builtin_amdgcn_s_barrier(); asm volatile("" ::: "memory");
        const int t = (wr * 4 + wc) * 64 + fq * 16 + fr;
        if (t < 256) { const f32x4 p = *(const PG8_LAS f32x4*)(ex + t * 4); st4_wt(SSo + (size_t)(u.pm * BM + t) * 4 + u.pn, (p[0] + p[1]) + (p[2] + p[3])); }
    }
};

typedef float f32x2 __attribute__((ext_vector_type(2)));
template <bool DRY> struct EpiUpT {
    static constexpr bool PERM = true, AFTER_DRAIN = false, AROWS8 = true;
    bf16_t* G; float* UE; const PG8_LAS float* rtab; const float* cw; const float* cb; PG8_LAS float* ex; const float* ssin;
    typedef PreRstd Pre;
    template <class Sched> __device__ __forceinline__ void pre_issue(Pre& P, const Sched& S, int tid) const { rstd_pre_issue(P, S, ssin, tid); }
    __device__ __forceinline__ void pre_fill(const Pre& P, int tid) const { rstd_pre_fill(P, rtab, tid); }
    __device__ __forceinline__ void operator()(f32x4 (&acc)[2][2][4][2], const Unit& u, int wr, int wc, int fr_, int fq_) const {
        int fr = fr_, fq = fq_; asm volatile("" : "+v"(fr), "+v"(fq));
        if (DRY) {
#pragma unroll
            for (int ai = 0; ai < 2; ++ai)
#pragma unroll
                for (int bj = 0; bj < 2; ++bj)
#pragma unroll
                    for (int m = 0; m < 4; ++m) asm volatile("" :: "v"(acc[ai][bj][m][0]), "v"(acc[ai][bj][m][1]));
            return; }
        const int rowb = u.pm * BM + (wr * 16 + fr) * 8;
#pragma unroll
        for (int ai = 0; ai < 2; ++ai)
#pragma unroll
            for (int m = 0; m < 4; ++m) { const float s = rtab[u.idx * 256 + (wr * 16 + fr) * 8 + 4 * ai + m];
#pragma unroll
                for (int bj = 0; bj < 2; ++bj)
#pragma unroll
                    for (int n = 0; n < 2; ++n) acc[ai][bj][m][n] *= s; }
        const int cidx = wc * 32 + 8 * fq;
        if (wr == 0 && fr == 15) {
#pragma unroll
            for (int k = 0; k < 2; ++k)
#pragma unroll
                for (int bj = 0; bj < 2; ++bj)
#pragma unroll
                    for (int n = 0; n < 2; ++n) *(PG8_LAS f32x4*)(ex + k * 256 + bj * 128 + cidx + 4 * n) = acc[1][bj][2 + k][n];
        }
        float* ue = UE + (size_t)u.pm * 4 * NUP + u.pn * 256 + cidx;
        if (wr == 0 && fr == 0) {
#pragma unroll
            for (int k = 0; k < 2; ++k)
#pragma unroll
                for (int bj = 0; bj < 2; ++bj)
#pragma unroll
                    for (int n = 0; n < 2; ++n) *(__attribute__((address_space(1))) f32x4*)(ue + (size_t)k * NUP + bj * 128 + 4 * n) = acc[0][bj][k][n];
        }
        if (wr == 1 && fr == 15) {
#pragma unroll
            for (int k = 0; k < 2; ++k)
#pragma unroll
                for (int bj = 0; bj < 2; ++bj)
#pragma unroll
                    for (int n = 0; n < 2; ++n) *(__attribute__((address_space(1))) f32x4*)(ue + (size_t)(2 + k) * NUP + bj * 128 + 4 * n) = acc[1][bj][2 + k][n];
        }
        const int ffc = u.pn * 128 + cidx;
        f32x4 cwv[8]; unsigned hold[8][2];
#define EPIUP_LOADW(c_) do { cwv[0] = *(const __attribute__((address_space(1))) f32x4*)(cw + (c_)); cwv[1] = *(const __attribute__((address_space(1))) f32x4*)(cw + NUP + (c_)); cwv[2] = *(const __attribute__((address_space(1))) f32x4*)(cw + 2 * NUP + (c_)); cwv[3] = *(const __attribute__((address_space(1))) f32x4*)(cb + (c_)); \
            cwv[4] = *(const __attribute__((address_space(1))) f32x4*)(cw + FF + (c_)); cwv[5] = *(const __attribute__((address_space(1))) f32x4*)(cw + NUP + FF + (c_)); cwv[6] = *(const __attribute__((address_space(1))) f32x4*)(cw + 2 * NUP + FF + (c_)); cwv[7] = *(const __attribute__((address_space(1))) f32x4*)(cb + FF + (c_)); } while (0)
        EPIUP_LOADW(ffc);
        asm volatile("s_waitcnt lgkmcnt(0)" ::: "memory"); __builtin_amdgcn_s_barrier(); asm volatile("" ::: "memory");
#pragma unroll
        for (int n = 0; n < 2; ++n) {
            const int c = ffc + 4 * n;
            if (n == 1) EPIUP_LOADW(c);
            const f32x4 w0v = cwv[0], w1v = cwv[1], w2v = cwv[2], bv = cwv[3], w0g = cwv[4], w1g = cwv[5], w2g = cwv[6], bg = cwv[7];
            f32x4 e6v = {0.f, 0.f, 0.f, 0.f}, e7v = e6v, e6g = e6v, e7g = e6v;
            if (wr == 1 && fr == 0) { const PG8_LAS float* e = ex + cidx + 4 * n; e6v = *(const PG8_LAS f32x4*)e; e6g = *(const PG8_LAS f32x4*)(e + 128); e7v = *(const PG8_LAS f32x4*)(e + 256); e7g = *(const PG8_LAS f32x4*)(e + 256 + 128); }
            f32x4 p2v, p1v, p2g, p1g;
#pragma unroll
            for (int j = 0; j < 4; ++j) { p2v[j] = dpp_mov<0x111>(e6v[j], acc[1][0][2][n][j]); p1v[j] = dpp_mov<0x111>(e7v[j], acc[1][0][3][n][j]);
                                          p2g[j] = dpp_mov<0x111>(e6g[j], acc[1][1][2][n][j]); p1g[j] = dpp_mov<0x111>(e7g[j], acc[1][1][3][n][j]); }
#define EPIUP_LO(v_) __builtin_shufflevector(v_, v_, 0, 1)
#define EPIUP_HI(v_) __builtin_shufflevector(v_, v_, 2, 3)
#pragma unroll
            for (int k = 0; k < 8; ++k) {
                const f32x4 uv = acc[k >> 2][0][k & 3][n], ug = acc[k >> 2][1][k & 3][n];
                f32x2 g2[2];
#pragma unroll
                for (int h = 0; h < 2; ++h) {
                    const f32x2 cv = __builtin_elementwise_fma(h ? EPIUP_HI(w2v) : EPIUP_LO(w2v), h ? EPIUP_HI(uv) : EPIUP_LO(uv), __builtin_elementwise_fma(h ? EPIUP_HI(w1v) : EPIUP_LO(w1v), h ? EPIUP_HI(p1v) : EPIUP_LO(p1v),
                                     __builtin_elementwise_fma(h ? EPIUP_HI(w0v) : EPIUP_LO(w0v), h ? EPIUP_HI(p2v) : EPIUP_LO(p2v), h ? EPIUP_HI(bv) : EPIUP_LO(bv))));
                    const f32x2 cg = __builtin_elementwise_fma(h ? EPIUP_HI(w2g) : EPIUP_LO(w2g), h ? EPIUP_HI(ug) : EPIUP_LO(ug), __builtin_elementwise_fma(h ? EPIUP_HI(w1g) : EPIUP_LO(w1g), h ? EPIUP_HI(p1g) : EPIUP_LO(p1g),
                                     __builtin_elementwise_fma(h ? EPIUP_HI(w0g) : EPIUP_LO(w0g), h ? EPIUP_HI(p2g) : EPIUP_LO(p2g), h ? EPIUP_HI(bg) : EPIUP_LO(bg))));
                    const f32x2 den = (f32x2){__builtin_amdgcn_exp2f(cg.x), __builtin_amdgcn_exp2f(cg.y)} + (f32x2){1.0f, 1.0f};
                    g2[h] = (cv * cg) * (f32x2){__builtin_amdgcn_rcpf(den.x), __builtin_amdgcn_rcpf(den.y)};
                }
                if (n == 0) { hold[k][0] = cvt_pk_bf16(g2[0].x, g2[0].y); hold[k][1] = cvt_pk_bf16(g2[1].x, g2[1].y); }
                else { u32x4 w; w.x = hold[k][0]; w.y = hold[k][1]; w.z = cvt_pk_bf16(g2[0].x, g2[0].y); w.w = cvt_pk_bf16(g2[1].x, g2[1].y);
                       st16_wt(G + (size_t)(rowb + k) * FF + ffc, w); }
                p2v = p1v; p1v = uv; p2g = p1g; p1g = ug;
            }
        }
    }
};
#undef EPIUP_LOADW
#undef EPIUP_LO
#undef EPIUP_HI
typedef EpiInT<false> EpiIn; typedef EpiUpT<false> EpiUp;
template <class Epi, class Sched, bool ALIGN_EPI = false, bool SP2 = false, bool TAIL = false>
__device__ __forceinline__ void gemm_phase(PG8_LAS unsigned char* lds, const Gemm g, const Sched& S, const Epi& E, const int wave_sgpr) {
    int tid_; asm volatile("v_mbcnt_lo_u32_b32 %0, -1, 0\n\tv_mbcnt_hi_u32_b32 %0, -1, %0" : "=v"(tid_)); tid_ += wave_sgpr * 64;
    const int tid = tid_, wid = __builtin_amdgcn_readfirstlane(tid >> 6), lane = tid & 63, wr = wid >> 2, wc = wid & 3, fr = lane & 15, fq = lane >> 4;
    const int K = g.K, nt = K / BK;
    unsigned voffA[2], voffB[2];
#pragma unroll
    for (int i = 0; i < 2; ++i) { int R, C; stage_rc(tid * 16 + i * 8192, R, C); const int Rb = Epi::PERM ? ((R & ~31) + perm32(R & 31)) : R;
        const int Ra = Epi::AROWS8 ? (((R >> 6) * 16 + (R & 15)) * 8 + ((R >> 4) & 3)) : R;
        voffA[i] = (unsigned)(Ra * K + C) * 2u; voffB[i] = (unsigned)(Rb * K + C) * 2u; }
    const size_t kstep = (size_t)(BK * 2);
    const size_t hstep = (size_t)HALF * K * 2;
    const size_t tstep = 2 * hstep;
    const size_t hstepA = Epi::AROWS8 ? (size_t)4 * K * 2 : hstep;
    const unsigned ldsw = (unsigned)wid * 1024u;
    const int aoff = lds_byte(wr * 64 + fr, fq * 8), boff = lds_byte(wc * 32 + fr, fq * 8);
#define PG8_SA(b, h) (((b) * 2 + (h)) * HTB)
#define PG8_SB(b, h) ((4 + (b) * 2 + (h)) * HTB)
#define PG8_STAGE(bufoff, gbase, voff) do { _Pragma("unroll") for (int _i = 0; _i < 2; ++_i) \
        __builtin_amdgcn_global_load_lds((const unsigned*)((const char*)(gbase) + (voff)[_i]), (PG8_LAS unsigned*)(lds + (bufoff) + ldsw + _i * 8192), 16, 0, 0); } while (0)
#define PG8_LDA(dst, b, h) do { _Pragma("unroll") for (int m = 0; m < 4; ++m) _Pragma("unroll") for (int k = 0; k < 2; ++k) dst[m][k] = *(const PG8_LAS bf16x8*)(lds + PG8_SA(b, h) + aoff + m * 2048 + k * 1024); } while (0)
#define PG8_LDB(dst, b, h) do { _Pragma("unroll") for (int n = 0; n < 2; ++n) _Pragma("unroll") for (int k = 0; k < 2; ++k) dst[n][k] = *(const PG8_LAS bf16x8*)(lds + PG8_SB(b, h) + boff + n * 2048 + k * 1024); } while (0)
#define PG8_MMA(ai, bj, At, Bt) do { __builtin_amdgcn_s_setprio(1); _Pragma("unroll") for (int m = 0; m < 4; ++m) _Pragma("unroll") for (int n = 0; n < 2; ++n) _Pragma("unroll") for (int k = 0; k < 2; ++k) \
        acc[ai][bj][m][n] = __builtin_amdgcn_mfma_f32_16x16x32_bf16(Bt[n][k], At[m][k], acc[ai][bj][m][n], 0, 0, 0); __builtin_amdgcn_s_setprio(0); } while (0)
#define PG8_WAIT_V(n) asm volatile("s_waitcnt vmcnt(" #n ")" ::: "memory")
#define PG8_WAIT_L(n) asm volatile("s_waitcnt lgkmcnt(" #n ")" ::: "memory")
#define PG8_BAR __builtin_amdgcn_s_barrier()
#define PG8_SCHED __builtin_amdgcn_sched_barrier(0)
    Unit cur, nxt; int ui = 0;
    if (!S.next(0, cur)) return;
    f32x4 acc[2][2][4][2];
#pragma unroll
    for (int a = 0; a < 2; ++a)
#pragma unroll
        for (int b = 0; b < 2; ++b)
#pragma unroll
            for (int m = 0; m < 4; ++m)
#pragma unroll
                for (int n = 0; n < 2; ++n) acc[a][b][m][n] = (f32x4){0.f, 0.f, 0.f, 0.f};
    bf16x8 At[4][2], B0[2][2], B1[2][2];
    const char* cA = (const char*)g.A + (size_t)cur.pm * tstep; const char* cB = (const char*)g.Bt + (size_t)cur.pn * tstep;
    S.a_ready(cur);
    typename Epi::Pre pre_; E.pre_issue(pre_, S, tid);
    if constexpr (SP2) {
        PG8_STAGE(PG8_SB(0, 0), cB, voffB); PG8_STAGE(PG8_SB(0, 1), cB + hstep, voffB); PG8_STAGE(PG8_SA(0, 0), cA, voffA); PG8_STAGE(PG8_SA(0, 1), cA + hstepA, voffA);
        E.pre_fill(pre_, tid);
        if (wr == 1) PG8_BAR;
        PG8_WAIT_V(2); PG8_BAR;
        PG8_STAGE(PG8_SB(1, 0), cB + kstep, voffB); PG8_STAGE(PG8_SA(1, 0), cA + kstep, voffA); PG8_STAGE(PG8_SB(1, 1), cB + hstep + kstep, voffB);
        PG8_WAIT_V(6); PG8_BAR;
    } else {
        PG8_STAGE(PG8_SB(0, 0), cB, voffB); PG8_STAGE(PG8_SA(0, 0), cA, voffA); PG8_STAGE(PG8_SB(0, 1), cB + hstep, voffB); PG8_STAGE(PG8_SA(0, 1), cA + hstepA, voffA);
        if (wr == 1) PG8_BAR;
        PG8_WAIT_V(4); PG8_BAR;
        PG8_STAGE(PG8_SB(1, 0), cB + kstep, voffB); PG8_STAGE(PG8_SA(1, 0), cA + kstep, voffA); PG8_STAGE(PG8_SB(1, 1), cB + hstep + kstep, voffB);
        PG8_WAIT_V(6); PG8_BAR;
    }
    for (;;) {
        const bool has_next = S.next(ui + 1, nxt);
        const char* nA = has_next ? (const char*)g.A + (size_t)nxt.pm * tstep : cA; const char* nB = has_next ? (const char*)g.Bt + (size_t)nxt.pn * tstep : cB;
        for (int t = 0; t < nt; t += 2) {
            const bool last = (t == nt - 2);
            const char* a1 = cA + (size_t)(t + 1) * kstep;
            const char* a2 = last ? nA : cA + (size_t)(t + 2) * kstep; const char* b2 = last ? nB : cB + (size_t)(t + 2) * kstep;
            const char* a3 = a2 + kstep; const char* b3 = b2 + kstep;
            if (last && has_next) S.a_ready(nxt);
            if constexpr (SP2) {
            if constexpr (TAIL) {
            const bool h0_ = cur.half == 0;
            PG8_LDB(B0, 0, 0); PG8_SCHED; if (h0_) PG8_LDA(At, 0, 0); PG8_STAGE(PG8_SA(1, 1), a1 + hstepA, voffA);
            PG8_WAIT_V(8); PG8_WAIT_L(0); PG8_BAR; if (h0_) PG8_MMA(0, 0, At, B0); PG8_BAR; PG8_SCHED;
            if (!h0_) PG8_LDA(At, 0, 1); PG8_STAGE(PG8_SB(0, 0), b2, voffB); PG8_STAGE(PG8_SB(0, 1), b2 + hstep, voffB); PG8_STAGE(PG8_SA(0, 0), a2, voffA);
            PG8_WAIT_V(8); PG8_WAIT_L(0); PG8_BAR; if (!h0_) PG8_MMA(1, 0, At, B0); PG8_BAR; PG8_SCHED;
            PG8_LDB(B0, 1, 0); PG8_SCHED; if (h0_) PG8_LDA(At, 1, 0); PG8_STAGE(PG8_SA(0, 1), a2 + hstepA, voffA);
            PG8_WAIT_V(8); PG8_WAIT_L(0); PG8_BAR; if (h0_) PG8_MMA(0, 0, At, B0); PG8_BAR; PG8_SCHED;
            if (!h0_) PG8_LDA(At, 1, 1); PG8_STAGE(PG8_SB(1, 0), b3, voffB); PG8_STAGE(PG8_SB(1, 1), b3 + hstep, voffB); PG8_STAGE(PG8_SA(1, 0), a3, voffA);
            PG8_WAIT_V(8); PG8_WAIT_L(0); PG8_BAR; if (!h0_) PG8_MMA(1, 0, At, B0); PG8_BAR; PG8_SCHED;
            } else {
            PG8_LDB(B0, 0, 0); PG8_LDB(B1, 0, 1); PG8_SCHED; PG8_LDA(At, 0, 0); PG8_STAGE(PG8_SA(1, 1), a1 + hstepA, voffA);
            PG8_WAIT_V(8); PG8_WAIT_L(0); PG8_BAR; PG8_MMA(0, 0, At, B0); PG8_MMA(0, 1, At, B1); PG8_BAR; PG8_SCHED;
            PG8_LDA(At, 0, 1); PG8_STAGE(PG8_SB(0, 0), b2, voffB); PG8_STAGE(PG8_SB(0, 1), b2 + hstep, voffB); PG8_STAGE(PG8_SA(0, 0), a2, voffA);
            PG8_WAIT_V(8); PG8_WAIT_L(0); PG8_BAR; PG8_MMA(1, 0, At, B0); PG8_MMA(1, 1, At, B1); PG8_BAR; PG8_SCHED;
            PG8_LDB(B0, 1, 0); PG8_LDB(B1, 1, 1); PG8_SCHED; PG8_LDA(At, 1, 0); PG8_STAGE(PG8_SA(0, 1), a2 + hstepA, voffA);
            PG8_WAIT_V(8); PG8_WAIT_L(0); PG8_BAR; PG8_MMA(0, 0, At, B0); PG8_MMA(0, 1, At, B1); PG8_BAR; PG8_SCHED;
            PG8_LDA(At, 1, 1); PG8_STAGE(PG8_SB(1, 0), b3, voffB); PG8_STAGE(PG8_SB(1, 1), b3 + hstep, voffB); PG8_STAGE(PG8_SA(1, 0), a3, voffA);
            PG8_WAIT_V(8); PG8_WAIT_L(0); PG8_BAR; PG8_MMA(1, 0, At, B0); PG8_MMA(1, 1, At, B1); PG8_BAR; PG8_SCHED;
            }
            } else {
            PG8_LDB(B0, 0, 0); PG8_SCHED; PG8_LDA(At, 0, 0); PG8_STAGE(PG8_SA(1, 1), a1 + hstepA, voffA);
            PG8_WAIT_L(8); PG8_BAR; PG8_WAIT_L(0); PG8_MMA(0, 0, At, B0); PG8_BAR; PG8_SCHED;
            PG8_LDB(B1, 0, 1); PG8_STAGE(PG8_SB(0, 0), b2, voffB);
            PG8_BAR; PG8_WAIT_L(0); PG8_MMA(0, 1, At, B1); PG8_BAR;
            PG8_LDA(At, 0, 1); PG8_STAGE(PG8_SA(0, 0), a2, voffA);
            PG8_BAR; PG8_WAIT_L(0); PG8_MMA(1, 0, At, B0); PG8_BAR; PG8_SCHED;
            PG8_STAGE(PG8_SB(0, 1), b2 + hstep, voffB);
            PG8_WAIT_V(6); PG8_BAR; PG8_MMA(1, 1, At, B1); PG8_BAR;
            PG8_LDB(B0, 1, 0); PG8_SCHED; PG8_LDA(At, 1, 0); PG8_STAGE(PG8_SA(0, 1), a2 + hstepA, voffA);
            PG8_WAIT_L(8); PG8_BAR; PG8_WAIT_L(0); PG8_MMA(0, 0, At, B0); PG8_BAR; PG8_SCHED;
            PG8_LDB(B1, 1, 1); PG8_STAGE(PG8_SB(1, 0), b3, voffB);
            PG8_BAR; PG8_WAIT_L(0); PG8_MMA(0, 1, At, B1); PG8_BAR;
            PG8_LDA(At, 1, 1); PG8_STAGE(PG8_SA(1, 0), a3, voffA);
            PG8_BAR; PG8_WAIT_L(0); PG8_MMA(1, 0, At, B0); PG8_BAR; PG8_SCHED;
            PG8_STAGE(PG8_SB(1, 1), b3 + hstep, voffB);
            PG8_WAIT_V(6); PG8_BAR; PG8_MMA(1, 1, At, B1); PG8_BAR;
            }
        }
        if constexpr (ALIGN_EPI) { if (wr == 0) PG8_BAR; }
        if constexpr (!Epi::AFTER_DRAIN) { E(acc, cur, wr, wc, fr, fq); S.done(cur); }
        if (!has_next) break;
#pragma unroll
        for (int a = 0; a < 2; ++a)
#pragma unroll
            for (int b = 0; b < 2; ++b)
#pragma unroll
                for (int m = 0; m < 4; ++m)
#pragma unroll
                    for (int n = 0; n < 2; ++n) acc[a][b][m][n] = (f32x4){0.f, 0.f, 0.f, 0.f};
        cur = nxt; cA = nA; cB = nB; ++ui;
        if constexpr (ALIGN_EPI) { if (wr == 1) PG8_BAR; }
    }
    PG8_WAIT_V(0);
    if constexpr (!ALIGN_EPI) { if (wr == 0) PG8_BAR; }
    PG8_BAR;
    if constexpr (Epi::AFTER_DRAIN) { E.fused(acc, cur, wr, wc, fr, fq, lds, wid, lane); S.done(cur); }
#undef PG8_SA
#undef PG8_SB
#undef PG8_STAGE
#undef PG8_LDA
#undef PG8_LDB
#undef PG8_MMA
#undef PG8_WAIT_V
#undef PG8_WAIT_L
#undef PG8_BAR
#undef PG8_SCHED
}
}
#define GAS __attribute__((address_space(1)))
#define LAS __attribute__((address_space(3)))
typedef unsigned short bf16;
typedef unsigned v4u __attribute__((ext_vector_type(4)));
typedef float f32x4 __attribute__((ext_vector_type(4)));
typedef short bf16x8 __attribute__((ext_vector_type(8)));
typedef GAS unsigned gu32;
typedef GAS unsigned long long gu64;
#define RLX_AGENT __ATOMIC_RELAXED, __HIP_MEMORY_SCOPE_AGENT
#define LDS_WAIT() asm volatile("s_waitcnt lgkmcnt(0)" ::: "memory")
#define VM_WAIT() asm volatile("s_waitcnt vmcnt(0)" ::: "memory")
__device__ __forceinline__ unsigned long long rt() { return __builtin_amdgcn_s_memrealtime(); }
__device__ __forceinline__ unsigned f2bf(float f) { unsigned u = __builtin_bit_cast(unsigned, f); return (u + 0x7fffu + ((u >> 16) & 1u)) >> 16; }
__device__ __forceinline__ unsigned pk2(float lo, float hi) { return f2bf(lo) | (f2bf(hi) << 16); }

#define XB_TMO      128
#define XB_XCNT(j)  (256  + 64 * (j))
#define XB_XSUB(j)  (1280 + 64 * (j))
#define XB_XGEN(j)  (2304 + 64 * (j))
#define XB_TOP      3328
#define XB_TOPGEN   3392
#define XCD_BAR_WORDS 3456
#define XB_SPIN_CAP (1u << 18)

__device__ __forceinline__ unsigned xb_ld(unsigned* p)              { return __hip_atomic_load(p, __ATOMIC_RELAXED, __HIP_MEMORY_SCOPE_AGENT); }
__device__ __forceinline__ unsigned xb_add(unsigned* p, unsigned v) { return __hip_atomic_fetch_add(p, v, __ATOMIC_RELAXED, __HIP_MEMORY_SCOPE_AGENT); }
__device__ __forceinline__ unsigned xb_xcc_id() { return (unsigned)__builtin_amdgcn_s_getreg((3 << 11) | 20) & 0xFu; }
#define XB_SPIN(cond, bar) do { unsigned _sp = 0; while (cond) { __builtin_amdgcn_s_sleep(1); \
    if ((++_sp & 255u) == 0u) { if (xb_ld(&(bar)[XB_TMO])) break; if (_sp > XB_SPIN_CAP) { atomicAdd(&(bar)[XB_TMO], 1u); break; } } } } while (0)

__device__ __forceinline__ int hw_lane() { int l; asm volatile("v_mbcnt_lo_u32_b32 %0, -1, 0\n\tv_mbcnt_hi_u32_b32 %0, -1, %0" : "=v"(l)); return l; }
struct XcdBarrier {
    int wave; unsigned* bar; unsigned x;
    volatile LAS unsigned* st;
};

__device__ __forceinline__ XcdBarrier xcd_barrier_post(unsigned* bar, volatile LAS unsigned* st, int wave) {
    XcdBarrier b; b.bar = bar; b.x = xb_xcc_id(); b.st = st; b.wave = wave;
    if (wave == 0 && hw_lane() == 0) (void)xb_add(&bar[XB_XCNT(b.x)], 1u);
    return b;
}
__device__ __forceinline__ void xcd_barrier_complete(unsigned* bar, unsigned x, unsigned& nloc, unsigned& nx) {
    const unsigned G = gridDim.x * gridDim.y * gridDim.z;
    unsigned sum, cnt, mine, sp = 0u;
    for (;;) {
        sum = 0u; cnt = 0u; mine = 0u;
#pragma unroll
        for (unsigned j = 0; j < 16; ++j) { const unsigned c = xb_ld(&bar[XB_XCNT(j)]); sum += c; cnt += (c > 0u) ? 1u : 0u; mine = (j == x) ? c : mine; }
        if (sum == G) break;
        __builtin_amdgcn_s_sleep(1);
        if ((++sp & 255u) == 0u) { if (xb_ld(&bar[XB_TMO])) break; if (sp > XB_SPIN_CAP) { atomicAdd(&bar[XB_TMO], 1u); break; } }
    }
    nloc = mine > 0u ? mine : 1u; nx = cnt > 0u ? cnt : 1u;
}

__device__ __forceinline__ unsigned xb_xcc_id_v() { unsigned r; asm volatile("s_getreg_b32 %0, hwreg(20, 0, 4)" : "=s"(r)); return r & 0xFu; }
__device__ __forceinline__ void xcd_barrier(const XcdBarrier& b_) {
    XcdBarrier b; { unsigned* bp = b_.bar; asm volatile("" : "+s"(bp)); b.bar = bp; } b.st = b_.st; b.wave = b_.wave; b.x = xb_xcc_id_v();
    asm volatile("s_waitcnt vmcnt(0)" ::: "memory");
    __syncthreads();
    if (b.wave == 0 && hw_lane() == 0) {
        unsigned* bar = b.bar;
        __builtin_amdgcn_s_waitcnt(0);
        unsigned nloc = b.st[0], nx = b.st[1];
        if (nloc == 0u) { xcd_barrier_complete(bar, b.x, nloc, nx); b.st[0] = nloc; b.st[1] = nx; }
        const unsigned old = xb_add(&bar[XB_XSUB(b.x)], 1u);
        const unsigned gen = old / nloc;
        if (old + 1u == (gen + 1u) * nloc) {
            __builtin_amdgcn_fence(__ATOMIC_RELEASE, "agent");
            asm volatile("s_waitcnt vmcnt(0)" ::: "memory");
            const unsigned og = xb_add(&bar[XB_TOP], 1u);
            const unsigned tg = og / nx;
            if (og + 1u == (tg + 1u) * nx) xb_add(&bar[XB_TOPGEN], 1u);
            else XB_SPIN(xb_ld(&bar[XB_TOPGEN]) == tg, bar);
            __builtin_amdgcn_fence(__ATOMIC_ACQUIRE, "agent");
            xb_add(&bar[XB_XGEN(b.x)], 1u);
            asm volatile("s_waitcnt vmcnt(0)" ::: "memory");
        } else {
            XB_SPIN(xb_ld(&bar[XB_XGEN(b.x)]) == gen, bar);
            __builtin_amdgcn_fence(__ATOMIC_ACQUIRE, "agent");
            asm volatile("s_waitcnt vmcnt(0)" ::: "memory");
        }
    }
    __syncthreads();
}

#define GB_WORD0 8192
__device__ __forceinline__ void group_barrier(const XcdBarrier& b_, const unsigned ngroup) {
    unsigned* bp = b_.bar; asm volatile("" : "+s"(bp));
    asm volatile("s_waitcnt vmcnt(0)" ::: "memory");
    __syncthreads();
    if (b_.wave == 0 && hw_lane() == 0) {
        __builtin_amdgcn_s_waitcnt(0);
        unsigned* cnt = bp + GB_WORD0 + 64u * ((unsigned)blockIdx.x & 7u);
        const unsigned old = xb_add(cnt, 1u);
        const unsigned target = (old / ngroup + 1u) * ngroup;
        XB_SPIN((int)(xb_ld(cnt) - target) < 0, bp);
        __builtin_amdgcn_fence(__ATOMIC_ACQUIRE, "agent");
        asm volatile("s_waitcnt vmcnt(0)" ::: "memory");
    }
    __syncthreads();
}

#define XB2_XSUB(j)  (4096 + 64 * (j))
#define XB2_TOP      5120
#define XB2_TOPGEN   5184
__device__ __forceinline__ void xcd_split_arrive(const XcdBarrier& b_) {
    XcdBarrier b; { unsigned* bp = b_.bar; asm volatile("" : "+s"(bp)); b.bar = bp; } b.st = b_.st; b.wave = b_.wave; b.x = xb_xcc_id_v();
    asm volatile("s_waitcnt vmcnt(0)" ::: "memory");
    __syncthreads();
    if (b.wave == 0 && hw_lane() == 0) {
        unsigned* bar = b.bar;
        __builtin_amdgcn_s_waitcnt(0);
        const unsigned nloc = b.st[0], nx = b.st[1];
        const unsigned old = xb_add(&bar[XB2_XSUB(b.x)], 1u);
        const unsigned gen = old / nloc;
        if (old + 1u == (gen + 1u) * nloc) {
            __builtin_amdgcn_fence(__ATOMIC_RELEASE, "agent");
            asm volatile("s_waitcnt vmcnt(0)" ::: "memory");
            const unsigned og = xb_add(&bar[XB2_TOP], 1u);
            const unsigned tg = og / nx;
            if (og + 1u == (tg + 1u) * nx) xb_add(&bar[XB2_TOPGEN], 1u);
        }
    }
}
__device__ __forceinline__ void xcd_split_wait(const XcdBarrier& b_, const unsigned k) {
    unsigned* bp = b_.bar; asm volatile("" : "+s"(bp));
    if (b_.wave == 0 && hw_lane() == 0) {
        XB_SPIN((int)(xb_ld(&bp[XB2_TOPGEN]) - k) < 0, bp);
        __builtin_amdgcn_fence(__ATOMIC_ACQUIRE, "agent");
        asm volatile("s_waitcnt vmcnt(0)" ::: "memory");
    }
    __syncthreads();
}
__device__ __forceinline__ void quad_barrier(const XcdBarrier& b_, const unsigned q) {
    unsigned* bp = b_.bar; asm volatile("" : "+s"(bp));
    asm volatile("s_waitcnt vmcnt(0)" ::: "memory");
    __syncthreads();
    if (b_.wave == 0 && hw_lane() == 0) {
        __builtin_amdgcn_s_waitcnt(0);
        unsigned* cnt = bp + GB_WORD0 + 64u * 12u + 64u * q;
        const unsigned old = xb_add(cnt, 1u);
        const unsigned target = (old / 4u + 1u) * 4u;
        XB_SPIN((int)(xb_ld(cnt) - target) < 0, bp);
        __builtin_amdgcn_fence(__ATOMIC_ACQUIRE, "agent");
        asm volatile("s_waitcnt vmcnt(0)" ::: "memory");
    }
    __syncthreads();
}

constexpr size_t MiB = 1u << 20;
constexpr size_t WS_BAR = 0, BAR_ZERO_BYTES = 65536;
constexpr size_t WS_CW = 512 * 1024;
constexpr size_t WS_SS = 1 * MiB;
constexpr size_t WS_KM = 3 * MiB;
constexpr size_t WS_KISS = 3 * MiB + 512 * 1024;
constexpr size_t WS_WI = 4 * MiB;
constexpr size_t WS_KIB = 5 * MiB;
constexpr size_t WS_UE = 7 * MiB;
constexpr size_t WS_MASK = 13 * MiB;
constexpr size_t WS_WIN = 21 * MiB, WS_WO = 30 * MiB, WS_WUP = 32 * MiB, WS_WDN = 43 * MiB;
constexpr size_t WS_XB = 54 * MiB;
constexpr size_t WS_Q = 86 * MiB, WS_K = 118 * MiB, WS_V = 150 * MiB, WS_QI = 182 * MiB;
constexpr size_t WS_G = 118 * MiB;
constexpr size_t WS_WUP2 = 214 * MiB;
constexpr size_t WS_WO2 = 226 * MiB;
constexpr size_t WS_END = 228 * MiB;
static_assert(WS_G + (size_t)M * FF * 2 <= WS_END && WS_WDN + 2 * (size_t)D * FF * 2 <= WS_XB && WS_WUP + (size_t)NUP * D * 2 <= WS_WDN && WS_WIN + (size_t)NIN_E * D * 2 <= WS_WO, "d_ws map");
static_assert(WS_UE + (size_t)64 * 4 * NUP * 4 <= WS_MASK && WS_MASK + (size_t)M * 64 * 8 <= WS_WIN, "d_ws map 2");

constexpr int RING_OFF = 0, RING_BYTES = 131072;
constexpr int AUX_OFF = 131072, AUX_BYTES = 25600;
constexpr int LDSCTL_OFF = AUX_OFF + AUX_BYTES, MISC_OFF = LDSCTL_OFF + 320;
constexpr int LDS_BYTES = 157184;
static_assert(MISC_OFF + 128 <= LDS_BYTES, "LDS map");
constexpr int NWAVES = 8;

struct Frame {
    LAS unsigned char* lds;
    volatile LAS unsigned* MISC;
    int tid, lane, wave, G, vcu;
    float* out; unsigned char* ws;
};
struct Args { const float* in[13]; float* out; unsigned char* ws; };
#define RELAUNDER(F) do { int l_ = hw_lane(); asm volatile("" : "+v"(l_)); (F).lane = l_; (F).tid = (F).wave * 64 + l_; \
    unsigned char* w_ = args.ws; asm volatile("" : "+s"(w_)); (F).ws = w_; } while (0)

__device__ __forceinline__ float wave_sum(float v) {
#pragma unroll
    for (int o = 1; o < 64; o <<= 1) v += __shfl_xor(v, o);
    return v;
}
__device__ __forceinline__ float wave_max(float v) {
#pragma unroll
    for (int o = 1; o < 64; o <<= 1) v = fmaxf(v, __shfl_xor(v, o));
    return v;
}
__device__ __forceinline__ int t5_bucket(int d) {
    if (d < 16) return d;
    int b = 16;
    b += (d >= 19); b += (d >= 21); b += (d >= 24); b += (d >= 27); b += (d >= 31); b += (d >= 35); b += (d >= 40); b += (d >= 46);
    b += (d >= 52); b += (d >= 59); b += (d >= 67); b += (d >= 77); b += (d >= 87); b += (d >= 99); b += (d >= 113);
    return b;
}

__device__ __forceinline__ void tr_item(const float* W, int ldn, int scol0, int nvalid, int k0, const float* gk, const float* sn, bf16* WT, int Kd, int drow0, LAS float* scr, int lane) {
    const int kq = lane >> 3, n4 = (lane & 7) * 4;
    f32x4 v[8]; float gsc[8];
#pragma unroll
    for (int i = 0; i < 8; ++i) { const int kk = 8 * i + kq;
        v[i] = (n4 < nvalid) ? *(const GAS f32x4*)(W + (size_t)(k0 + kk) * ldn + scol0 + n4) : (f32x4){0.f, 0.f, 0.f, 0.f};
        gsc[i] = gk ? gk[k0 + kk] : 1.f; }
#pragma unroll
    for (int i = 0; i < 8; ++i) { const int kk = 8 * i + kq; const f32x4 t = v[i] * gsc[i]; LAS float* d = scr + kk * 33 + n4; d[0] = t[0]; d[1] = t[1]; d[2] = t[2]; d[3] = t[3]; }
    LDS_WAIT(); asm volatile("" ::: "memory");
    const int c = lane & 7;
#pragma unroll
    for (int j = 0; j < 4; ++j) { const int n = (lane >> 3) + 8 * j; const LAS float* s = scr + (8 * c) * 33 + n; const float f = sn ? sn[(drow0 + n) & 63] : 1.f;
        v4u o; o.x = pk2(s[0 * 33] * f, s[1 * 33] * f); o.y = pk2(s[2 * 33] * f, s[3 * 33] * f); o.z = pk2(s[4 * 33] * f, s[5 * 33] * f); o.w = pk2(s[6 * 33] * f, s[7 * 33] * f);
        *(GAS v4u*)(WT + (size_t)(drow0 + n) * Kd + k0 + 8 * c) = o; }
    LDS_WAIT(); asm volatile("" ::: "memory");
}
__device__ __forceinline__ void convert_layer(Frame& F, const Args& A, int L, int gw, int NGW, const int which = 15) {
    LAS float* scr = (LAS float*)(F.lds + RING_OFF + F.wave * 16384);
    const int j = L >> 1; const bool even = !(L & 1);
    const int nb_in = even ? NIN_E / 32 : NIN_O / 32;
    const int I_IN = 16 * nb_in, I_O = 16 * 32, I_UP = 16 * (NUP / 32), I_DN = (FF / 64) * (D / 32);
    const int NIT = I_IN + I_O + I_UP + I_DN;
    bf16* WinT = (bf16*)(F.ws + WS_WIN); bf16* WoT = (bf16*)(F.ws + ((L & 1) ? WS_WO2 : WS_WO)); bf16* WupT = (bf16*)(F.ws + ((L & 1) ? WS_WUP2 : WS_WUP)); bf16* WdnT = (bf16*)(F.ws + WS_WDN) + (size_t)(L & 1) * D * FF;
    for (int it = gw; it < NIT; it += NGW) {
        int r = it;
        if (r < I_IN) {
            if (!(which & 1)) continue;
            const int kb = r / nb_in, nb = r % nb_in, dr = 32 * nb;
            if (even) {
                int sc0, nv = 32; const float* sn = nullptr;
                if (dr < 512) sc0 = dr; else if (dr < 1024) sc0 = 1536 + (dr - 512); else if (dr < 1536) sc0 = 512 + (dr - 1024); else if (dr < 2048) sc0 = 2048 + (dr - 1536);
                else if (dr < 2560) sc0 = 1024 + (dr - 2048); else if (dr < 3072) sc0 = 2560 + (dr - 2560); else if (dr < 4096) { sc0 = dr; sn = A.in[2] + j * 64; }
                else if (dr < 4160) sc0 = dr; else if (dr == 4160) { sc0 = 4160; nv = 16; } else { sc0 = 0; nv = 0; }
                tr_item(A.in[1] + (size_t)j * D * EVEN_IN, EVEN_IN, sc0, nv, 64 * kb, A.in[6] + L * D, sn, WinT, D, dr, scr, F.lane);
            } else {
                tr_item(A.in[3] + (size_t)j * D * NIN_O, NIN_O, dr, 32, 64 * kb, A.in[6] + L * D, nullptr, WinT, D, dr, scr, F.lane);
            }
            continue;
        }
        r -= I_IN;
        if (r < I_O) { if (!(which & 2)) continue; const int kb = r / 32, nb = r % 32; tr_item(A.in[4] + (size_t)L * D * D, D, 32 * nb, 32, 64 * kb, nullptr, nullptr, WoT, D, 32 * nb, scr, F.lane); continue; }
        r -= I_O;
        if (r < I_UP) { if (!(which & 4)) continue; const int kb = r / (NUP / 32), nb = r % (NUP / 32); const int p = nb >> 3, half = (nb >> 2) & 1, c0 = (nb & 3) * 32;
            tr_item(A.in[8] + (size_t)L * D * NUP, NUP, half * FF + 128 * p + c0, 32, 64 * kb, A.in[7] + L * D, nullptr, WupT, D, 32 * nb, scr, F.lane); continue; }
        r -= I_UP;
        if (which & 8) { const int kb = r / 32, nb = r % 32; tr_item(A.in[11] + (size_t)L * FF * D, D, 32 * nb, 32, 64 * kb, nullptr, nullptr, WdnT, FF, 32 * nb, scr, F.lane); }
    }
}
__device__ __forceinline__ void p0_prologue(Frame& F, const Args& A) {
    const int gw = F.vcu * NWAVES + F.wave, NGW = F.G * NWAVES;
    const float* x = A.in[0]; bf16* XB = (bf16*)(F.ws + WS_XB); float* SS0 = (float*)(F.ws + WS_SS) + (size_t)M * 4;
    for (int m = gw; m < M; m += NGW) {
        const GAS f32x4* xr = (const GAS f32x4*)(x + (size_t)m * D) + F.lane;
        f32x4 v[4]; float s = 0.f;
#pragma unroll
        for (int jj = 0; jj < 4; ++jj) { v[jj] = xr[64 * jj]; s += (v[jj].x * v[jj].x + v[jj].y * v[jj].y) + (v[jj].z * v[jj].z + v[jj].w * v[jj].w); }
        s = wave_sum(s);
        if (F.lane < 4) SS0[(size_t)m * 4 + F.lane] = F.lane == 0 ? s : 0.f;
        GAS unsigned long long* o8 = (GAS unsigned long long*)(XB + (size_t)m * D) + F.lane;
#pragma unroll
        for (int jj = 0; jj < 4; ++jj) o8[64 * jj] = (unsigned long long)pk2(v[jj].x, v[jj].y) | ((unsigned long long)pk2(v[jj].z, v[jj].w) << 32);
    }
    { float* CW = (float*)(F.ws + WS_CW);
        for (int i = F.vcu * (NWAVES * 64) + F.tid; i < DEPTH * 4 * NUP; i += F.G * NWAVES * 64) { const int l = i / (4 * NUP), r = i - l * 4 * NUP, row = r / NUP, c = r - row * NUP;
            const float v = row < 3 ? A.in[9][(size_t)l * 3 * NUP + (size_t)row * NUP + c] : A.in[10][(size_t)l * NUP + c];
            CW[i] = v * (c < FF ? -0.6931471805599453f : -1.4426950408889634f); } }
    convert_layer(F, A, 0, F.vcu * NWAVES + F.wave, F.G * NWAVES, 1);
}
__device__ __forceinline__ void final_norm(Frame& F, const Args& A) {
    const int gw = F.vcu * NWAVES + F.wave, NGW = F.G * NWAVES;
    const float* SS = (const float*)(F.ws + WS_SS) + (size_t)M * 4; const GAS f32x4* g4 = (const GAS f32x4*)A.in[12] + 2 * F.lane;
    const bf16* XB = (const bf16*)(F.ws + WS_XB);
    f32x4 g[4];
#pragma unroll
    for (int jj = 0; jj < 2; ++jj) { g[2 * jj] = g4[128 * jj]; g[2 * jj + 1] = g4[128 * jj + 1]; }
    const bool grp = F.G == 256; const int m0 = grp ? 2048 * (F.vcu >> 5) + (F.vcu & 31) * NWAVES + F.wave : gw, mstep = grp ? 256 : NGW, mend = grp ? 2048 * (F.vcu >> 5) + 2048 : M;
    for (int m = m0; m < mend; m += mstep) {
        const GAS v4u* xr = (const GAS v4u*)(XB + (size_t)m * D) + F.lane; GAS f32x4* o = (GAS f32x4*)(F.out + (size_t)m * D) + 2 * F.lane;
        const float rs = pg8::row_rstd(SS, m);
#pragma unroll
        for (int jj = 0; jj < 2; ++jj) { const v4u b = xr[64 * jj];
            f32x4 v0 = {__uint_as_float(b.x << 16), __uint_as_float(b.x & 0xffff0000u), __uint_as_float(b.y << 16), __uint_as_float(b.y & 0xffff0000u)};
            f32x4 v1 = {__uint_as_float(b.z << 16), __uint_as_float(b.z & 0xffff0000u), __uint_as_float(b.w << 16), __uint_as_float(b.w & 0xffff0000u)};
            o[128 * jj] = v0 * rs * g[2 * jj]; o[128 * jj + 1] = v1 * rs * g[2 * jj + 1]; }
    }
}
__device__ __forceinline__ void fix_rows(Frame& F, const Args& A, int pm, int L) {
    const float* UE = (const float*)(F.ws + WS_UE); bf16* G = (bf16*)(F.ws + WS_G);
    const float* cw = A.in[9] + (size_t)L * 3 * NUP; const float* cb = A.in[10] + (size_t)L * NUP;
    const float* um2 = UE + ((size_t)(pm - 1) * 4 + 2) * NUP; const float* um1 = um2 + NUP; const float* u0 = UE + (size_t)pm * 4 * NUP; const float* u1 = u0 + NUP;
    constexpr int NQ = FF / 4;
#define FIX_LD(p_) (*(const GAS f32x4*)(p_))
    f32x4 wv[2][8], uv[2][8];
#pragma unroll
    for (int k = 0; k < 2; ++k) { const int q = F.tid + k * (NWAVES * 64), c = 4 * (q < NQ ? q : 0), iv = (c >> 7) * 256 + (c & 127), ig = iv + 128;
        wv[k][0] = FIX_LD(cw + c); wv[k][1] = FIX_LD(cw + NUP + c); wv[k][2] = FIX_LD(cw + 2 * NUP + c); wv[k][3] = FIX_LD(cb + c);
        wv[k][4] = FIX_LD(cw + FF + c); wv[k][5] = FIX_LD(cw + NUP + FF + c); wv[k][6] = FIX_LD(cw + 2 * NUP + FF + c); wv[k][7] = FIX_LD(cb + FF + c);
        uv[k][0] = FIX_LD(um2 + iv); uv[k][1] = FIX_LD(um1 + iv); uv[k][2] = FIX_LD(u0 + iv); uv[k][3] = FIX_LD(u1 + iv);
        uv[k][4] = FIX_LD(um2 + ig); uv[k][5] = FIX_LD(um1 + ig); uv[k][6] = FIX_LD(u0 + ig); uv[k][7] = FIX_LD(u1 + ig); }
#undef FIX_LD
#pragma unroll
    for (int k = 0; k < 2; ++k) { const int q = F.tid + k * (NWAVES * 64);
        if (q < NQ) { const int c = 4 * q; unsigned g0[4], g1[4];
#pragma unroll
            for (int e = 0; e < 4; ++e) {
                const float w0v = wv[k][0][e], w1v = wv[k][1][e], w2v = wv[k][2][e], bv = wv[k][3][e], w0g = wv[k][4][e], w1g = wv[k][5][e], w2g = wv[k][6][e], bg = wv[k][7][e];
                const float a2v = uv[k][0][e], a1v = uv[k][1][e], a0v = uv[k][2][e], b0v = uv[k][3][e], a2g = uv[k][4][e], a1g = uv[k][5][e], a0g = uv[k][6][e], b0g = uv[k][7][e];
                float cv = bv + w0v * a2v + w1v * a1v + w2v * a0v, cg = bg + w0g * a2g + w1g * a1g + w2g * a0g;
                g0[e] = f2bf(cv * cg * __builtin_amdgcn_rcpf(1.0f + __builtin_amdgcn_exp2f(-cg * LOG2E)));
                cv = bv + w0v * a1v + w1v * a0v + w2v * b0v; cg = bg + w0g * a1g + w1g * a0g + w2g * b0g;
                g1[e] = f2bf(cv * cg * __builtin_amdgcn_rcpf(1.0f + __builtin_amdgcn_exp2f(-cg * LOG2E))); }
            asm volatile("global_store_dwordx2 %0, %1, off sc0 sc1\n\ts_nop 1" :: "v"(G + (size_t)(pm * 256) * FF + c), "v"((unsigned long long)(g0[0] | (g0[1] << 16)) | ((unsigned long long)(g0[2] | (g0[3] << 16)) << 32)) : "memory");
            asm volatile("global_store_dwordx2 %0, %1, off sc0 sc1\n\ts_nop 1" :: "v"(G + (size_t)(pm * 256 + 1) * FF + c), "v"((unsigned long long)(g1[0] | (g1[1] << 16)) | ((unsigned long long)(g1[2] | (g1[3] << 16)) << 32)) : "memory"); } }
}

typedef __bf16 bf16x2_t __attribute__((ext_vector_type(2)));
__device__ __forceinline__ float dot2bf(unsigned a, unsigned b, float c) { return __builtin_amdgcn_fdot2_f32_bf16(__builtin_bit_cast(bf16x2_t, a), __builtin_bit_cast(bf16x2_t, b), c, false); }
__device__ __forceinline__ float bflo(unsigned w) { return __uint_as_float(w << 16); }
__device__ __forceinline__ float bfhi(unsigned w) { return __uint_as_float(w & 0xffff0000u); }
struct LaneAcc { float m, l; f32x4 o[16]; };
__device__ __forceinline__ void la_init(LaneAcc& A) { A.m = -INFINITY; A.l = 0.f;
#pragma unroll
    for (int i = 0; i < 16; ++i) A.o[i] = (f32x4){0.f, 0.f, 0.f, 0.f}; }
__device__ __forceinline__ void la_key(LaneAcc& A, const v4u (&q)[8], const bf16* krow, const bf16* vrow, float bias2) {
    v4u k[8];
#pragma unroll
    for (int i = 0; i < 8; ++i) k[i] = *(const GAS v4u*)(krow + 8 * i);
    float s0 = 0.f, s1 = 0.f, s2 = 0.f, s3 = 0.f;
#pragma unroll
    for (int i = 0; i < 8; ++i) { s0 = dot2bf(q[i].x, k[i].x, s0); s1 = dot2bf(q[i].y, k[i].y, s1); s2 = dot2bf(q[i].z, k[i].z, s2); s3 = dot2bf(q[i].w, k[i].w, s3); }
    const float s = (s0 + s1) + (s2 + s3) + bias2;
    if (s > A.m) { const float f = __builtin_amdgcn_exp2f(A.m - s); A.l *= f;
#pragma unroll
        for (int i = 0; i < 16; ++i) A.o[i] *= f;
        A.m = s; }
    const float p = __builtin_amdgcn_exp2f(s - A.m); A.l += p;
    v4u v[8];
#pragma unroll
    for (int i = 0; i < 8; ++i) v[i] = *(const GAS v4u*)(vrow + 8 * i);
#pragma unroll
    for (int i = 0; i < 8; ++i) {
        A.o[2 * i] += p * (f32x4){bflo(v[i].x), bfhi(v[i].x), bflo(v[i].y), bfhi(v[i].y)};
        A.o[2 * i + 1] += p * (f32x4){bflo(v[i].z), bfhi(v[i].z), bflo(v[i].w), bfhi(v[i].w)};
    }
}
__device__ __forceinline__ void la_finish(LaneAcc& A, bf16* orow, int lane) {
    const float Mx = wave_max(A.m);
    const float f = (A.m == -INFINITY) ? 0.f : __builtin_amdgcn_exp2f(A.m - Mx);
    const float Lt = wave_sum(A.l * f); const float inv = 1.0f / Lt;
#pragma unroll
    for (int i = 0; i < 16; ++i) { f32x4 t = A.o[i] * f; t[0] = wave_sum(t[0]); t[1] = wave_sum(t[1]); t[2] = wave_sum(t[2]); t[3] = wave_sum(t[3]); A.o[i] = t * inv; }
    if (lane == 0) {
#pragma unroll
        for (int i = 0; i < 8; ++i) { v4u w; w.x = pk2(A.o[2 * i][0], A.o[2 * i][1]); w.y = pk2(A.o[2 * i][2], A.o[2 * i][3]); w.z = pk2(A.o[2 * i + 1][0], A.o[2 * i + 1][1]); w.w = pk2(A.o[2 * i + 1][2], A.o[2 * i + 1][3]);
            *(GAS v4u*)(orow + 8 * i) = w; }
    }
}
__device__ __forceinline__ float rel_bias2(const float* rb, int h, int d) { return rb[t5_bucket(d) * 16 + h] * LOG2E; }

__device__ __forceinline__ void simple_moba(Frame& F, const Args& A, int layer_j) {
    const int gw = F.vcu * NWAVES + F.wave, NGW = F.G * NWAVES, lane = F.lane;
    bf16* Q = (bf16*)(F.ws + WS_Q); const bf16* K = (const bf16*)(F.ws + WS_K); const bf16* V = (const bf16*)(F.ws + WS_V);
    const float* KM = (const float*)(F.ws + WS_KM); const float* rb = A.in[5];
    for (int task = gw; task < M * 8; task += NGW) {
        const int h = task & 7, row = task >> 3, b = row >> 12, t = row & 4095, own = t >> 8;
        bf16* qrow = Q + (size_t)row * D + h * HD;
        v4u q[8];
#pragma unroll
        for (int i = 0; i < 8; ++i) q[i] = *(const GAS v4u*)(qrow + 8 * i);
        float g = -INFINITY;
        if (lane < own) { const GAS f32x4* km = (const GAS f32x4*)(KM + ((size_t)((b * 8 + h) * 16 + lane)) * 128); float a = 0.f;
#pragma unroll
            for (int i = 0; i < 8; ++i) { const f32x4 k0 = km[2 * i] + km[16 + 2 * i], k1 = km[2 * i + 1] + km[16 + 2 * i + 1];
                a += bflo(q[i].x) * k0[0] + bfhi(q[i].x) * k0[1] + bflo(q[i].y) * k0[2] + bfhi(q[i].y) * k0[3] + bflo(q[i].z) * k1[0] + bfhi(q[i].z) * k1[1] + bflo(q[i].w) * k1[2] + bfhi(q[i].w) * k1[3]; }
            g = a; }
        int sel0 = -1, sel1 = -1, sel2 = -1, nsel = 0;
#pragma unroll
        for (int r = 0; r < 3; ++r) { const float mx = wave_max(g);
            if (mx > -INFINITY) { const unsigned long long bal = __ballot(g == mx); const int idx = __ffsll((long long)bal) - 1;
                if (r == 0) sel0 = idx; else if (r == 1) sel1 = idx; else sel2 = idx; nsel = r + 1; if (lane == idx) g = -INFINITY; } }
        const int nown = t - own * 256 + 1, ntot = nsel * 256 + nown;
        LaneAcc A; la_init(A);
        for (int e = lane; e < ntot; e += 64) {
            const int bi = e >> 8; const int blk = bi < nsel ? (bi == 0 ? sel0 : (bi == 1 ? sel1 : sel2)) : own;
            const int s = blk * 256 + (e & 255); const size_t kr = (size_t)(b * SEQ + s) * D + h * HD;
            la_key(A, q, K + kr, V + kr, rel_bias2(rb, h, t - s));
        }
        la_finish(A, qrow, lane);
    }
}
__device__ __forceinline__ void simple_dsa(Frame& F, const Args& A) {
    const int gw = F.vcu * NWAVES + F.wave, NGW = F.G * NWAVES, lane = F.lane;
    bf16* Q = (bf16*)(F.ws + WS_Q); const bf16* K = (const bf16*)(F.ws + WS_K); const bf16* V = (const bf16*)(F.ws + WS_V);
    const unsigned long long* MASK = (const unsigned long long*)(F.ws + WS_MASK); const float* rb = A.in[5];
    for (int task = gw; task < M * 8; task += NGW) {
        const int h = 8 + (task & 7), row = task >> 3, b = row >> 12, t = row & 4095;
        bf16* qrow = Q + (size_t)row * D + h * HD;
        v4u q[8];
#pragma unroll
        for (int i = 0; i < 8; ++i) q[i] = *(const GAS v4u*)(qrow + 8 * i);
        unsigned long long w = MASK[(size_t)row * 64 + lane];
        LaneAcc A; la_init(A);
        while (w) { const int bit = __ffsll((long long)w) - 1; w &= w - 1; const int s = lane * 64 + bit;
            if (s <= t) { const size_t kr = (size_t)(b * SEQ + s) * D + h * HD; la_key(A, q, K + kr, V + kr, rel_bias2(rb, h, t - s)); } }
        la_finish(A, qrow, lane);
    }
}
__device__ __forceinline__ void simple_dilated(Frame& F, const Args& A) {
    const int gw = F.vcu * NWAVES + F.wave, NGW = F.G * NWAVES, lane = F.lane;
    bf16* Q = (bf16*)(F.ws + WS_Q); const bf16* K = (const bf16*)(F.ws + WS_K); const bf16* V = (const bf16*)(F.ws + WS_V); const float* rb = A.in[5];
    for (int task = gw; task < M * 16; task += NGW) {
        const int h = task & 15, row = task >> 4, b = row >> 12, t = row & 4095;
        bf16* qrow = Q + (size_t)row * D + h * HD;
        v4u q[8];
#pragma unroll
        for (int i = 0; i < 8; ++i) q[i] = *(const GAS v4u*)(qrow + 8 * i);
        LaneAcc A; la_init(A);
        for (int e = lane; e < 387; e += 64) { const int p = e / 129, i = e - 129 * p, d = i << (2 * p), s = t - d;
            if (s >= 0) { const size_t kr = (size_t)(b * SEQ + s) * D + h * HD; la_key(A, q, K + kr, V + kr, rel_bias2(rb, h, d)); } }
        la_finish(A, qrow, lane);
    }
}
__device__ __forceinline__ unsigned f2key(float f) { const unsigned u = __float_as_uint(f); return (u & 0x80000000u) ? ~u : (u | 0x80000000u); }
__device__ __forceinline__ void select_row(LAS float* sc, LAS unsigned* hist, int t, int row, unsigned long long* MASK, int lane) {
    const int nj = (t >> 6) + 1;
    unsigned thr = 0u; int need_eq = 0x7fffffff;
    if (t + 1 > 256) {
        unsigned prefix = 0u; int kk = 256;
#pragma unroll 1
        for (int pass = 0; pass < 4; ++pass) { const int sh = 24 - 8 * pass;
            hist[lane] = 0u; hist[64 + lane] = 0u; hist[128 + lane] = 0u; hist[192 + lane] = 0u;
            LDS_WAIT(); asm volatile("" ::: "memory");
            for (int jj = 0; jj < nj; ++jj) { const int s = jj * 64 + lane; const unsigned key = f2key(sc[s]);
                const bool in = (s <= t) && (pass == 0 || (key >> (sh + 8)) == prefix);
                if (in) __hip_atomic_fetch_add(hist + ((key >> sh) & 255u), 1u, __ATOMIC_RELAXED, __HIP_MEMORY_SCOPE_WORKGROUP); }
            LDS_WAIT(); asm volatile("" ::: "memory");
            const unsigned c0 = hist[4 * lane], c1 = hist[4 * lane + 1], c2 = hist[4 * lane + 2], c3 = hist[4 * lane + 3];
            const int ls = (int)(c0 + c1 + c2 + c3);
            int suf = ls;
#pragma unroll
            for (int o = 1; o < 64; o <<= 1) { const int v = __shfl_down(suf, o); if (lane + o < 64) suf += v; }
            const int above = suf - ls;
            const bool mine = (above < kk) && (suf >= kk);
            const unsigned long long bal = __ballot(mine); const int src = __ffsll((long long)bal) - 1;
            int bsel = 0, krem = kk;
            { int acc = above; if (acc + (int)c3 >= kk) { bsel = 3; krem = kk - acc; } else { acc += (int)c3; if (acc + (int)c2 >= kk) { bsel = 2; krem = kk - acc; } else { acc += (int)c2;
                  if (acc + (int)c1 >= kk) { bsel = 1; krem = kk - acc; } else { acc += (int)c1; bsel = 0; krem = kk - acc; } } } }
            bsel = __shfl(bsel + 4 * lane, src); krem = __shfl(krem, src);
            prefix = (prefix << 8) | (unsigned)bsel; kk = krem;
            LDS_WAIT(); asm volatile("" ::: "memory");
        }
        thr = prefix; need_eq = kk;
    }
    unsigned long long myword = 0ull;
    for (int jj = 0; jj < nj; ++jj) { const int s = jj * 64 + lane; const unsigned key = f2key(sc[s]); const bool valid = s <= t;
        unsigned long long gt = __ballot(valid && (t + 1 <= 256 || key > thr));
        if (t + 1 > 256 && need_eq > 0) { unsigned long long eq = __ballot(valid && key == thr); int c = __popcll(eq);
            while (c > need_eq) { eq &= ~(1ull << (63 - __clzll((long long)eq))); --c; }
            gt |= eq; need_eq -= c; }
        if (lane == jj) myword = gt; }
    MASK[(size_t)row * 64 + lane] = myword;
}
__device__ __forceinline__ void simple_indexer(Frame& F, int layer_j) {
    const int gw = F.vcu * NWAVES + F.wave, NGW = F.G * NWAVES, lane = F.lane;
    const bf16* QI = (const bf16*)(F.ws + WS_QI); const bf16* KIB = (const bf16*)(F.ws + WS_KIB); const float* WI = (const float*)(F.ws + WS_WI);
    unsigned long long* MASK = (unsigned long long*)(F.ws + WS_MASK);
    LAS float* sc = (LAS float*)(F.lds + RING_OFF) + F.wave * 4096;
    LAS v4u* qs = (LAS v4u*)(F.lds + AUX_OFF + F.wave * 2048);
    LAS unsigned* hist = (LAS unsigned*)(F.lds + AUX_OFF + F.wave * 2048);
    for (int row = gw; row < M; row += NGW) {
        const int b = row >> 12, t = row & 4095, nj = (t >> 6) + 1;
        { const GAS v4u* src = (const GAS v4u*)(QI + (size_t)row * D); qs[lane] = src[lane]; qs[64 + lane] = src[64 + lane]; }
        f32x4 w4[4];
#pragma unroll
        for (int i = 0; i < 4; ++i) w4[i] = *(const GAS f32x4*)(WI + (size_t)row * 16 + 4 * i);
        LDS_WAIT(); asm volatile("" ::: "memory");
        for (int jj = 0; jj < nj; ++jj) {
            const int s = jj * 64 + lane; const size_t kr = (size_t)(b * SEQ + s);
            v4u k[8];
#pragma unroll
            for (int i = 0; i < 8; ++i) k[i] = *(const GAS v4u*)(KIB + kr * 64 + 8 * i);
            float score = 0.f;
#pragma unroll
            for (int h = 0; h < 16; ++h) { float a0 = 0.f, a1 = 0.f;
#pragma unroll
                for (int i = 0; i < 8; ++i) { const v4u qq = qs[h * 8 + i]; a0 = dot2bf(qq.x, k[i].x, a0); a1 = dot2bf(qq.y, k[i].y, a1); a0 = dot2bf(qq.z, k[i].z, a0); a1 = dot2bf(qq.w, k[i].w, a1); }
                score += fmaxf(a0 + a1, 0.f) * w4[h >> 2][h & 3]; }
            sc[s] = (s <= t) ? score : -INFINITY;
        }
        LDS_WAIT(); asm volatile("" ::: "memory");
        select_row(sc, hist, t, row, MASK, lane);
        LDS_WAIT(); asm volatile("" ::: "memory");
    }
}

namespace attn_body {
using bf16=__hip_bfloat16;
using bf16x8=__attribute__((ext_vector_type(8)))short;
using s16x4=__attribute__((ext_vector_type(4)))short;
using f32x16=__attribute__((ext_vector_type(16)))float;
using u32x4=__attribute__((ext_vector_type(4)))unsigned;
constexpr int BATCH=4,NHEAD=16,SEQ=4096,D=64,DM=NHEAD*D;
constexpr int NW=8,QBLK=32,QB=QBLK*NW,KVBLK=64,NQB=SEQ/QB;
constexpr int ATTN_PITCH=DM, ATTN_UNIT_ROWS=QB;
__device__ __forceinline__ int crow(int r,int hi){return (r&3)+8*(r>>2)+4*hi;}
#define SBAR() __builtin_amdgcn_sched_barrier(0)
__device__ __forceinline__ void cmask(f32x16&p0,f32x16&p1,int jb,int qrel,int hi){
  const float NEG=-INFINITY; int kb=64*jb+4*hi;
  #pragma unroll
  for(int r=0;r<16;++r){int kv=kb+(r&3)+8*(r>>2); if(kv>qrel)p0[r]=NEG; if(kv+32>qrel)p1[r]=NEG;}
}

constexpr int NSLOT=3, SLOTB=8192;
constexpr int LDS_K=0, LDS_V=NSLOT*SLOTB, LDS_WS=2*NSLOT*SLOTB, LDS_OST=LDS_WS+NW*64*4, LDS_LT=LDS_OST+NW*4096, LDS_MK=LDS_LT+2560*4, LDS_KM=LDS_MK+NW*768, LDS_BYTES=LDS_KM+4096;
constexpr float C2=::C2;
__device__ __forceinline__ void glds16(const void*gsrc,unsigned lds_dst){unsigned keep;
  asm volatile("s_mov_b32 %0, m0\n\ts_mov_b32 m0, %2\n\ts_nop 0\n\tglobal_load_lds_dwordx4 %1, off\n\ts_mov_b32 m0, %0":"=&s"(keep):"v"(gsrc),"s"(lds_dst):"memory");}
__device__ __forceinline__ void glds4(const void*gsrc,unsigned lds_dst){unsigned keep;
  asm volatile("s_mov_b32 %0, m0\n\ts_mov_b32 m0, %2\n\ts_nop 0\n\tglobal_load_lds_dword %1, off\n\ts_mov_b32 m0, %0":"=&s"(keep):"v"(gsrc),"s"(lds_dst):"memory");}
__device__ __forceinline__ float max3f(float a,float b,float c){float r;asm("v_max3_f32 %0, %1, %2, %3":"=v"(r):"v"(a),"v"(b),"v"(c));return r;}
__device__ __forceinline__ float max2f(float a,float b){float r;asm("v_max_f32_e32 %0, %1, %2":"=v"(r):"v"(a),"v"(b));return r;}
__device__ __forceinline__ float fadd_s(float a,float b){float r;asm("v_add_f32_e32 %0, %1, %2":"=v"(r):"v"(a),"v"(b));return r;}
__device__ __forceinline__ float fsub_s(float a,float b){float r;asm("v_sub_f32_e32 %0, %1, %2":"=v"(r):"v"(a),"v"(b));return r;}
typedef float f32x4_t __attribute__((ext_vector_type(4))); __device__ __forceinline__ float bf2f(short v){return __uint_as_float(((unsigned)(unsigned short)v)<<16);}
typedef float f32x2_t __attribute__((ext_vector_type(2))); typedef __bf16 bf16x2_t __attribute__((ext_vector_type(2)));
__device__ __forceinline__ unsigned cvtpk_s(float lo,float hi){f32x2_t v={lo,hi};bf16x2_t b=__builtin_convertvector(v,bf16x2_t);return __builtin_bit_cast(unsigned,b);}
#define WAIT_BAR(N) asm volatile("s_waitcnt vmcnt(" #N ") lgkmcnt(0)\n\ts_barrier":::"memory")

__device__ __forceinline__ void qkt(f32x16&p0,f32x16&p1,const char*Kslot,const bf16x8*qr,const f32x16&negm,int r32,int hi){
  const char*kb=Kslot+hi*1024+r32*16;
  #pragma unroll
  for(int d0=0;d0<4;++d0){
    const bf16x8 b0=*reinterpret_cast<const bf16x8*>(kb+d0*2048);
    const bf16x8 b1=*reinterpret_cast<const bf16x8*>(kb+d0*2048+512);
    if(d0==0){p0=__builtin_amdgcn_mfma_f32_32x32x16_bf16(b0,qr[0],negm,0,0,0);p1=__builtin_amdgcn_mfma_f32_32x32x16_bf16(b1,qr[0],negm,0,0,0);}
    else{p0=__builtin_amdgcn_mfma_f32_32x32x16_bf16(b0,qr[d0],p0,0,0,0);p1=__builtin_amdgcn_mfma_f32_32x32x16_bf16(b1,qr[d0],p1,0,0,0);}}
}
typedef __attribute__((address_space(3))) const char* lds_cptr;
typedef short v4i16_t __attribute__((ext_vector_type(4)));
__device__ __forceinline__ void kload8(bf16x8*kf,lds_cptr kp){
  kf[0]=*(const __attribute__((address_space(3))) bf16x8*)(kp);      kf[1]=*(const __attribute__((address_space(3))) bf16x8*)(kp+512);
  kf[2]=*(const __attribute__((address_space(3))) bf16x8*)(kp+2048); kf[3]=*(const __attribute__((address_space(3))) bf16x8*)(kp+2560);
  kf[4]=*(const __attribute__((address_space(3))) bf16x8*)(kp+4096); kf[5]=*(const __attribute__((address_space(3))) bf16x8*)(kp+4608);
  kf[6]=*(const __attribute__((address_space(3))) bf16x8*)(kp+6144); kf[7]=*(const __attribute__((address_space(3))) bf16x8*)(kp+6656);
}
__device__ __forceinline__ void kload2(bf16x8*kf,lds_cptr kp,int j){ kf[2*j]=*(const __attribute__((address_space(3))) bf16x8*)(kp+j*2048); kf[2*j+1]=*(const __attribute__((address_space(3))) bf16x8*)(kp+j*2048+512); }
__device__ __forceinline__ s16x4 vtr(lds_cptr p){ return __builtin_bit_cast(s16x4,__builtin_amdgcn_ds_read_tr16_b64_v4i16((__attribute__((address_space(3))) v4i16_t*)p)); }
__device__ __forceinline__ float rowmax(const f32x16&p0,const f32x16&p1){
  float a=max3f(p0[0],p0[1],p1[0]),b=max3f(p0[2],p0[3],p1[1]);a=max3f(a,p1[2],p1[3]);
  #pragma unroll
  for(int r=4;r<16;r+=4){a=max3f(a,p0[r],p0[r+1]);b=max3f(b,p0[r+2],p0[r+3]);a=max3f(a,p1[r],p1[r+1]);b=max3f(b,p1[r+2],p1[r+3]);}
  const float m=max2f(a,b);
  auto rr=__builtin_amdgcn_permlane32_swap(__float_as_uint(m),__float_as_uint(m),false,false);
  return max2f(__uint_as_float(rr[0]),__uint_as_float(rr[1]));
}
__device__ __forceinline__ void pv(f32x16*o,int vb,bf16x8 pa0,bf16x8 pa1,bf16x8 pa2,bf16x8 pa3){
  #pragma unroll
  for(int d0=0;d0<2;++d0){s16x4 lo[4],hi[4];
    #pragma unroll
    for(int ks=0;ks<4;++ks){
      asm volatile("ds_read_b64_tr_b16 %0,%1 offset:%c2":"=&v"(lo[ks]):"v"(vb),"i"(d0*4096+ks*1024):"memory");
      asm volatile("ds_read_b64_tr_b16 %0,%1 offset:%c2":"=&v"(hi[ks]):"v"(vb),"i"(d0*4096+ks*1024+512):"memory");}
    asm volatile("s_waitcnt lgkmcnt(0)":::"memory");SBAR();
    #define PK(k) (bf16x8){lo[k][0],lo[k][1],lo[k][2],lo[k][3],hi[k][0],hi[k][1],hi[k][2],hi[k][3]}
    o[d0]=__builtin_amdgcn_mfma_f32_32x32x16_bf16(pa0,PK(0),o[d0],0,0,0);
    o[d0]=__builtin_amdgcn_mfma_f32_32x32x16_bf16(pa1,PK(1),o[d0],0,0,0);
    o[d0]=__builtin_amdgcn_mfma_f32_32x32x16_bf16(pa2,PK(2),o[d0],0,0,0);
    o[d0]=__builtin_amdgcn_mfma_f32_32x32x16_bf16(pa3,PK(3),o[d0],0,0,0);
    #undef PK
  }
}

__device__ __forceinline__ void preissue_kv0(const bf16*K,const bf16*V,int b,int h,char*shm,int wid){
  int ln_=hw_lane(); asm volatile("":"+v"(ln_));
  const unsigned lds0=(unsigned)(uintptr_t)shm; const unsigned kdst=lds0+LDS_K+wid*1024, vdst=lds0+LDS_V+wid*1024;
  const bf16*ks=K+((long)b*SEQ+ln_)*DM+h*D+wid*8;
  const bf16*vs=V+((long)b*SEQ+16*(wid&3)+(ln_>>2))*DM+h*D+(wid>>2)*32+(ln_&3)*8;
  glds16(ks,(unsigned)__builtin_amdgcn_readfirstlane(kdst)); glds16(vs,(unsigned)__builtin_amdgcn_readfirstlane(vdst)); glds16(ks+(long)KVBLK*DM,(unsigned)__builtin_amdgcn_readfirstlane(kdst+SLOTB)); glds16(ks+(long)(2*KVBLK)*DM,(unsigned)__builtin_amdgcn_readfirstlane(kdst+2*SLOTB));
}
#ifndef ATTN_STORE16
#define ATTN_STORE16(p,v) asm volatile("global_store_dwordx4 %0, %1, off sc0 sc1\n\ts_nop 1"::"v"(p),"v"(v):"memory")
#endif
struct QP{ int w; };
template<int MODE,int THRL> __device__ __forceinline__ void attn_unit(int b,int h,int qb,const bf16*Q,const bf16*__restrict__ K,const bf16*__restrict__ V,bf16*O,char*shm,const int wid,const float*rb,const float*KM,const unsigned*MASK32,const bool build_tab,QP&qp_,const bf16*OF=nullptr,float*ML=nullptr,const int nb_=-1,const int nh_=0,const int nqb_=0,const int pre_=0,const bool nx_=false,const bool qpre_=false){
  const int lane=hw_lane(),tid=wid*64+lane,r32=lane&31,hi=lane>>5;
  constexpr int RS=(MODE==3)?16:1; constexpr long RDM=(long)DM*RS;
  constexpr int DTOP=(MODE==2||MODE==4)?2303:383, TSZ=(MODE==2||MODE==4)?2560:640;
  const int cls=(MODE==3)?qb:0, qbe=(MODE==3)?0:qb;
  const long rowbase=(long)b*SEQ+cls; const int q0=qbe*QB;
  const bf16*Qw=Q+rowbase*DM+(long)(q0+wid*QBLK)*RDM+h*D;
  const int T0=(MODE==2&&qbe>8)?4*(qbe-8):((MODE==4&&qbe>2)?4*(qbe-2):0);
  const bf16*Kh=K+rowbase*DM+(long)(T0*KVBLK)*RDM+h*D,*Vh=V+rowbase*DM+(long)(T0*KVBLK)*RDM+h*D;
  const unsigned lds0=(unsigned)(uintptr_t)shm;
  float*wsf=(float*)(shm+LDS_WS)+wid*64;
  const bf16*ksrc=Kh+(long)lane*RDM+wid*8;
  const bf16*vsrc=Vh+(long)(16*(wid&3)+(lane>>2))*RDM+(wid>>2)*32+(lane&3)*8;
  const unsigned kdst=lds0+LDS_K+wid*1024, vdst=lds0+LDS_V+wid*1024;
  #define DMA_K(t,slot) glds16(ksrc+(long)(t)*KVBLK*RDM,(unsigned)__builtin_amdgcn_readfirstlane(kdst+(slot)))
  #define DMA_V(t,slot) glds16(vsrc+(long)(t)*KVBLK*RDM,(unsigned)__builtin_amdgcn_readfirstlane(vdst+(slot)))
  const int vb0=(int)(lds0+LDS_V)+((lane>>4)&1)*32+(lane&3)*8+(4*hi+((lane&15)>>2))*64;
  const char*Kbase=shm+LDS_K; bf16x8 kf[8];
  const lds_cptr shm3=(lds_cptr)shm; const lds_cptr kp0=shm3+LDS_K+hi*1024+r32*16; const lds_cptr vp0=shm3+LDS_V+((lane>>4)&1)*32+(lane&3)*8+(4*hi+((lane&15)>>2))*64;
  const int NT=(q0+QB)/KVBLK-T0;
  if(build_tab){ float*lt=(float*)(shm+LDS_LT); const float b31=rb[31*16+h];
    for(int i=tid;i<TSZ;i+=NW*64){ const int d=DTOP-i; float v;
      if(d<0)v=-INFINITY; else if(MODE==3)v=(d>=33&&d<=128)?0.f:-INFINITY; else{ const float nb=(d<113)?(rb[t5_bucket(d)*16+h]-b31)*LOG2E:0.f;
        if(MODE==2||MODE==4){ const int wfar=(MODE==2)?2048:512; const int m=(d<=128?1:0)+(((d&3)==0&&d<=512)?1:0)+(((d&15)==0&&d<=wfar)?1:0); v=(m==0)?-INFINITY:nb+(m==1?0.f:(m==2?1.f:1.5849625007f)); } else v=nb; }
      lt[i]=v; } }
  if(MODE==0&&build_tab){ float*kms=(float*)(shm+LDS_KM);
    for(int i=tid;i<16*64;i+=NW*64){ const float*p=KM+((size_t)((b*8+h)*16+(i>>6)))*128+(i&63); kms[i]=p[0]+p[64]; } }
  const unsigned*msrc=MASK32+((size_t)(rowbase+q0+wid*QBLK+(lane>>1)))*128+(lane&1);
  const unsigned mdst=lds0+LDS_MK+wid*768;
  #define DMA_M(t,off) glds4(msrc+2*(t),(unsigned)__builtin_amdgcn_readfirstlane(mdst+(off)))
  #define WAITB(n2,n3) do{ if(MODE==1){WAIT_BAR(n3);}else{WAIT_BAR(n2);} }while(0)
  if(MODE==1&&pre_!=1){DMA_M(0,0);DMA_M(1,256);}
  if(!pre_){ DMA_K(0,0);DMA_V(0,0);DMA_K(1,SLOTB); }
  bf16x8 qr[4];
  const unsigned qst_off=(wid<6)?(unsigned)(LDS_BYTES+wid*4096):(unsigned)(131072+(wid-6)*4096);
  if(!qpre_){ _Pragma("unroll") for(int d0=0;d0<4;++d0)qr[d0]=*(const __attribute__((address_space(1))) bf16x8*)(&Qw[(long)r32*RDM+d0*16+hi*8]); }
  float mhat=0.f,l_reg=0.f;f32x16 o[2];o[0]=f32x16{};o[1]=f32x16{};f32x16 negm=f32x16{};asm volatile("":"+v"(negm));
  if(MODE==4){ int r32i_=r32, hii_=hi; asm volatile("":"+v"(r32i_),"+v"(hii_)); const size_t qi_=((size_t)(rowbase+q0+wid*QBLK+r32i_))*16+h;
    mhat=*(const __attribute__((address_space(1))) float*)(ML+qi_*2); { const float lf_=*(const __attribute__((address_space(1))) float*)(ML+qi_*2+1); l_reg=(hii_==0)?lf_:0.f; }
    _Pragma("unroll") for(int r=0;r<16;++r)negm[r]=-mhat; asm volatile("":"+v"(negm));
    _Pragma("unroll") for(int d_=0;d_<2;++d_) _Pragma("unroll") for(int r=0;r<16;++r)o[d_][r]=bf2f(*(const __attribute__((address_space(1))) short*)((const short*)OF+(rowbase+q0+wid*QBLK+crow(r,hii_))*DM+h*D+d_*32+r32i_)); }
  const int qrel=wid*QBLK+r32;
  unsigned selmask=0u;
  const lds_cptr ltb=shm3+LDS_LT+4*(DTOP-64*(NT-4)-qrel+4*hi);
  const lds_cptr mkb=shm3+LDS_MK+wid*768+r32*8;
  #define HOOK_TAB(P0,P1,t) do{ const lds_cptr lp_=ltb+256*(t); \
      _Pragma("unroll") for(int r=0;r<16;++r){ P0[r]+=*(const __attribute__((address_space(3))) float*)(lp_+4*((r&3)+8*(r>>2))); P1[r]+=*(const __attribute__((address_space(3))) float*)(lp_+4*((r&3)+8*(r>>2)+32)); } }while(0)
  #define HOOK_SEL(P0,P1,t) do{ if(MODE==0){ if((t)<NT-4){ if(!((selmask>>((t)>>2))&1u)){ _Pragma("unroll") for(int r=0;r<16;++r){P0[r]=-INFINITY;P1[r]=-INFINITY;} } } } \
      if(MODE==1){ const unsigned long long w_=*(const __attribute__((address_space(3))) unsigned long long*)(mkb+(sl_cur>>5)); const unsigned lo_=((unsigned)w_)>>(4*hi), hi_=((unsigned)(w_>>32))>>(4*hi);     \
        _Pragma("unroll") for(int r=0;r<16;++r){ const unsigned m0_=(unsigned)__builtin_amdgcn_sbfe((int)lo_,(r&3)+8*(r>>2),1), m1_=(unsigned)__builtin_amdgcn_sbfe((int)hi_,(r&3)+8*(r>>2),1);     \
          P0[r]=__uint_as_float((__float_as_uint(P0[r])&m0_)|(~m0_&0xFF800000u)); P1[r]=__uint_as_float((__float_as_uint(P1[r])&m1_)|(~m1_&0xFF800000u)); } } }while(0)
  #define CMASK(P0,P1,t) do{ HOOK_SEL(P0,P1,t); if(MODE>=2||(t)>=NT-6)HOOK_TAB(P0,P1,t); }while(0)
  bool resc=false;
  #define START(P0,P1) do{ const float rm=rowmax(P0,P1); resc=false; \
    { const float dl=__builtin_fmaxf(rm,0.f); mhat=fadd_s(mhat,dl); \
      _Pragma("unroll") for(int r=0;r<16;++r){P0[r]=fsub_s(P0[r],dl);P1[r]=fsub_s(P1[r],dl);} \
      _Pragma("unroll") for(int r=0;r<16;++r)negm[r]=-mhat; asm volatile("":"+v"(negm)); \
      if(MODE==4){ const float f_=__builtin_amdgcn_exp2f(-dl); l_reg*=f_; if(hi==0)wsf[r32]=f_; resc=true; } } \
    _Pragma("unroll") for(int r=0;r<16;++r)P0[r]=__builtin_amdgcn_exp2f(P0[r]); }while(0)
  #define RESC() do{ if(resc){ asm volatile("s_waitcnt lgkmcnt(0)":::"memory"); \
      _Pragma("unroll") for(int d_=0;d_<2;++d_) _Pragma("unroll") for(int r=0;r<16;++r)o[d_][r]*=wsf[crow(r,hi)]; } }while(0)
  f32x16 pA0,pA1,pB0,pB1;
  int sl_prev=0,sl_cur=0,sl_next=SLOTB;
  #define ROT() do{sl_prev=sl_cur;sl_cur=sl_next;sl_next=(sl_next==(NSLOT-1)*SLOTB)?0:sl_next+SLOTB;}while(0)
  if(!pre_){DMA_K(2,2*SLOTB);}
  if(qpre_){ WAIT_BAR(0);
    _Pragma("unroll") for(int d0=0;d0<4;++d0)qr[d0]=*(const __attribute__((address_space(3))) bf16x8*)(shm3+qst_off+(r32>>3)*1024+((r32&7)*8+((d0*2+hi)^(r32&7)))*16); }
  else WAIT_BAR(3);
  if(MODE==0){
    if(qb<=3)selmask=(1u<<qb)-1u;
    else{ float v1=-INFINITY,v2=-INFINITY,v3=-INFINITY; int i1=0,i2=0,i3=0; const lds_cptr kmb=shm3+LDS_KM+32*hi;
      for(int n=0;n<qb;++n){ float a=0.f;
        _Pragma("unroll") for(int d0=0;d0<4;++d0){ const f32x4_t k0=*(const __attribute__((address_space(3))) f32x4_t*)(kmb+n*256+d0*64), k1=*(const __attribute__((address_space(3))) f32x4_t*)(kmb+n*256+d0*64+16); const bf16x8 qq=qr[d0];
          a+=bf2f(qq[0])*k0[0]+bf2f(qq[1])*k0[1]+bf2f(qq[2])*k0[2]+bf2f(qq[3])*k0[3]+bf2f(qq[4])*k1[0]+bf2f(qq[5])*k1[1]+bf2f(qq[6])*k1[2]+bf2f(qq[7])*k1[3]; }
        a+=__shfl_xor(a,32);
        if(a>v1){v3=v2;i3=i2;v2=v1;i2=i1;v1=a;i1=n;} else if(a>v2){v3=v2;i3=i2;v2=a;i2=n;} else if(a>v3){v3=a;i3=n;} }
      selmask=(1u<<i1)|(1u<<i2)|(1u<<i3); } }
  qkt(pA0,pA1,Kbase,qr,negm,r32,hi);asm volatile("s_nop 15\n\ts_nop 7":"+v"(pA0),"+v"(pA1));CMASK(pA0,pA1,0);
  START(pA0,pA1); if(MODE==4){RESC();}
  _Pragma("unroll") for(int r=0;r<16;++r)pA1[r]=__builtin_amdgcn_exp2f(pA1[r]);
  WAIT_BAR(0);
  DMA_K(3,0);DMA_V(1,SLOTB); if(MODE==1){DMA_M(2,512);}
  ROT();
  kload8(kf,kp0+sl_cur);
  WAITB(2,3);
  s16x4 vlo[8],vhi[8]; u32x4 pw0,pw1,pw2,pw3;
  #define PKW(P,B) cvtpk_s(P[B],P[B+1])
  #define PAF(k) __builtin_bit_cast(bf16x8,pw##k)
  #define VFR(i) (bf16x8){vlo[i][0],vlo[i][1],vlo[i][2],vlo[i][3],vhi[i][0],vhi[i][1],vhi[i][2],vhi[i][3]}
  #define PIN(x) asm volatile("":"+v"(x))
  #define MX3(a,b,c) __builtin_fmaxf(__builtin_fmaxf((a),(b)),(c))
  #define GAPA(MF,A0,A1,A2,A3,W0,W1,PW) do{ MF; sacc+=A0; sacc+=A1; sacc+=A2; sacc+=A3; PIN(sacc); W0; W1; PIN(PW); SBAR(); }while(0)
  #define EX(v) __builtin_amdgcn_exp2f(v)
  #define GAPB(MF,X,B) do{ MF; X[B]=EX(X[B]); X[B+1]=EX(X[B+1]); X[B+2]=EX(X[B+2]); X[B+3]=EX(X[B+3]); PIN(X); SBAR(); }while(0)
  #define VRD(i) do{ vlo[i]=vtr(vp_+(((i)>>2)*4096+((i)&3)*1024)); vhi[i]=vtr(vp_+(((i)>>2)*4096+((i)&3)*1024+512)); }while(0)
  #define KRD(G,j) do{ if(G){ kload2(kf,kp0+sl_next,j); SBAR(); } }while(0)
  #define STEP(C0,C1,P0,P1,t,GK,GV,GL) do{ SBAR(); \
    const lds_cptr vp_=vp0+sl_prev; \
    VRD(0); SBAR(); float sacc=(P0[0]+P0[1]); \
    GAPA(C0=__builtin_amdgcn_mfma_f32_32x32x16_bf16(kf[0],qr[0],negm,0,0,0), P0[2],P0[3],P0[4],P0[5],     pw0[0]=PKW(P0,0), pw0[1]=PKW(P0,2), pw0); \
    VRD(4); SBAR(); GAPA(C1=__builtin_amdgcn_mfma_f32_32x32x16_bf16(kf[1],qr[0],negm,0,0,0), P0[6],P0[7],P0[8],P0[9],     pw0[2]=PKW(P0,4), pw0[3]=PKW(P0,6), pw0); \
    VRD(1); SBAR(); GAPA(C0=__builtin_amdgcn_mfma_f32_32x32x16_bf16(kf[2],qr[1],C0,0,0,0),   P0[10],P0[11],P0[12],P0[13], pw1[0]=PKW(P0,8), pw1[1]=PKW(P0,10), pw1); \
    VRD(5); SBAR(); GAPA(C1=__builtin_amdgcn_mfma_f32_32x32x16_bf16(kf[3],qr[1],C1,0,0,0),   P0[14],P0[15],P1[0],P1[1],   pw1[2]=PKW(P0,12),pw1[3]=PKW(P0,14), pw1); \
    VRD(2); SBAR(); GAPA(C0=__builtin_amdgcn_mfma_f32_32x32x16_bf16(kf[4],qr[2],C0,0,0,0),   P1[2],P1[3],P1[4],P1[5],     pw2[0]=PKW(P1,0), pw2[1]=PKW(P1,2), pw2); \
    VRD(6); SBAR(); GAPA(C1=__builtin_amdgcn_mfma_f32_32x32x16_bf16(kf[5],qr[2],C1,0,0,0),   P1[6],P1[7],P1[8],P1[9],     pw2[2]=PKW(P1,4), pw2[3]=PKW(P1,6), pw2); \
    VRD(3); SBAR(); GAPA(C0=__builtin_amdgcn_mfma_f32_32x32x16_bf16(kf[6],qr[3],C0,0,0,0),   P1[10],P1[11],P1[12],P1[13], pw3[0]=PKW(P1,8), pw3[1]=PKW(P1,10), pw3); \
    VRD(7); SBAR(); GAPA(C1=__builtin_amdgcn_mfma_f32_32x32x16_bf16(kf[7],qr[3],C1,0,0,0),   P1[14],P1[15],0.f,0.f,       pw3[2]=PKW(P1,12),pw3[3]=PKW(P1,14), pw3); \
    l_reg+=sacc; \
    if(GK){DMA_K((t)+3,sl_cur);} if(GV){DMA_V((t)+1,sl_next);} if(MODE==1){ if((t)+2<NT){DMA_M((t)+2,sl_prev>>5);} } \
    CMASK(C0,C1,t); \
    { float a=MX3(C0[0],C0[1],C1[0]),b=MX3(C0[2],C0[3],C1[1]); a=MX3(a,C1[2],C1[3]); \
      _Pragma("unroll") for(int r=4;r<16;r+=4){a=MX3(a,C0[r],C0[r+1]);b=MX3(b,C0[r+2],C0[r+3]);a=MX3(a,C1[r],C1[r+1]);b=MX3(b,C1[r+2],C1[r+3]);} \
      float rm=__builtin_fmaxf(a,b); { auto rr=__builtin_amdgcn_permlane32_swap(__float_as_uint(rm),__float_as_uint(rm),false,false); rm=__builtin_fmaxf(__uint_as_float(rr[0]),__uint_as_float(rr[1])); } \
      resc=false; \
      if(__builtin_expect(__any(rm>(float)THRL),0)){ const float dl=__builtin_fmaxf(rm,0.f); mhat+=dl; \
        _Pragma("unroll") for(int r=0;r<16;++r){C0[r]-=dl;C1[r]-=dl;} \
        _Pragma("unroll") for(int r=0;r<16;++r)negm[r]=-mhat; asm volatile("":"+v"(negm)); \
        const float f=__builtin_amdgcn_exp2f(-dl); l_reg*=f; if(hi==0)wsf[r32]=f; resc=true; } } \
    SBAR(); \
    GAPB(o[0]=__builtin_amdgcn_mfma_f32_32x32x16_bf16(PAF(0),VFR(0),o[0],0,0,0), C0,0); \
    GAPB(o[1]=__builtin_amdgcn_mfma_f32_32x32x16_bf16(PAF(0),VFR(4),o[1],0,0,0), C0,4); \
    KRD(GL,0); GAPB(o[0]=__builtin_amdgcn_mfma_f32_32x32x16_bf16(PAF(1),VFR(1),o[0],0,0,0), C0,8); \
    KRD(GL,1); GAPB(o[1]=__builtin_amdgcn_mfma_f32_32x32x16_bf16(PAF(1),VFR(5),o[1],0,0,0), C0,12); \
    KRD(GL,2); GAPB(o[0]=__builtin_amdgcn_mfma_f32_32x32x16_bf16(PAF(2),VFR(2),o[0],0,0,0), C1,0); \
    KRD(GL,3); GAPB(o[1]=__builtin_amdgcn_mfma_f32_32x32x16_bf16(PAF(2),VFR(6),o[1],0,0,0), C1,4); \
    GAPB(o[0]=__builtin_amdgcn_mfma_f32_32x32x16_bf16(PAF(3),VFR(3),o[0],0,0,0), C1,8); \
    GAPB(o[1]=__builtin_amdgcn_mfma_f32_32x32x16_bf16(PAF(3),VFR(7),o[1],0,0,0), C1,12); \
    }while(0)
  int t=1;
  #undef CMASK
  #define CMASK(P0,P1,t) do{ HOOK_SEL(P0,P1,t); if(MODE>=2)HOOK_TAB(P0,P1,t); }while(0)
  for(;t+7<NT;t+=2){
    STEP(pB0,pB1,pA0,pA1,t,true,true,true);     WAITB(2,3); RESC(); ROT();
    STEP(pA0,pA1,pB0,pB1,t+1,true,true,true);   WAITB(2,3); RESC(); ROT();
  }
  #undef CMASK
  #define CMASK(P0,P1,t) do{ HOOK_SEL(P0,P1,t); if(MODE>=2||(t)>=NT-6)HOOK_TAB(P0,P1,t); }while(0)
  #define ENDW(tt) do{ if((tt)+3<NT){WAITB(2,3);} else if((tt)+2<NT){WAITB(1,2);} else {WAIT_BAR(0);} }while(0)
  for(;t+1<NT;t+=2){
    STEP(pB0,pB1,pA0,pA1,t,(t+3<NT),(t+1<NT),(t+1<NT));       ENDW(t);   RESC(); ROT();
    STEP(pA0,pA1,pB0,pB1,t+1,(t+4<NT),(t+2<NT),(t+2<NT));     ENDW(t+1); RESC(); ROT();
  }
  STEP(pB0,pB1,pA0,pA1,NT-1,false,false,false); RESC();
  { float sacc=pB0[0]+pB0[1]; _Pragma("unroll") for(int r=2;r<16;++r)sacc+=pB0[r]; _Pragma("unroll") for(int r=0;r<16;++r)sacc+=pB1[r]; l_reg+=sacc;
    pw0=(u32x4){PKW(pB0,0),PKW(pB0,2),PKW(pB0,4),PKW(pB0,6)};pw1=(u32x4){PKW(pB0,8),PKW(pB0,10),PKW(pB0,12),PKW(pB0,14)};pw2=(u32x4){PKW(pB1,0),PKW(pB1,2),PKW(pB1,4),PKW(pB1,6)};pw3=(u32x4){PKW(pB1,8),PKW(pB1,10),PKW(pB1,12),PKW(pB1,14)};
    SBAR(); pv(o,vb0+sl_cur,PAF(0),PAF(1),PAF(2),PAF(3)); }
  asm volatile("s_waitcnt lgkmcnt(0)\n\ts_barrier":::"memory");
  if(nb_>=0){ int ln_=lane; asm volatile("":"+v"(ln_));
    const bool far_n=(MODE==3)&&!nx_, near_n=(MODE==4)||((MODE==3)&&nx_); const long RDM_n=far_n?(long)DM*16:(long)DM;
    const int cls_n=far_n?nqb_:0, qbe_n=far_n?0:nqb_; const long rowbase_n=(long)nb_*SEQ+cls_n; const int q0_n=qbe_n*QB;
    const int T0_n=(MODE==2&&qbe_n>8)?4*(qbe_n-8):((near_n&&qbe_n>2)?4*(qbe_n-2):0);
    const bf16*ks_n=K+rowbase_n*DM+(long)(T0_n*KVBLK)*RDM_n+nh_*D+(long)ln_*RDM_n+wid*8;
    const bf16*vs_n=V+rowbase_n*DM+(long)(T0_n*KVBLK)*RDM_n+nh_*D+(long)(16*(wid&3)+(ln_>>2))*RDM_n+(wid>>2)*32+(ln_&3)*8;
    if(MODE==1){ const unsigned*ms_n=MASK32+((size_t)(rowbase_n+q0_n+wid*QBLK+(ln_>>1)))*128+(ln_&1); glds4(ms_n,(unsigned)__builtin_amdgcn_readfirstlane(mdst)); glds4(ms_n+2,(unsigned)__builtin_amdgcn_readfirstlane(mdst+256)); }
    glds16(ks_n,(unsigned)__builtin_amdgcn_readfirstlane(kdst)); glds16(vs_n,(unsigned)__builtin_amdgcn_readfirstlane(vdst)); glds16(ks_n+(long)KVBLK*RDM_n,(unsigned)__builtin_amdgcn_readfirstlane(kdst+SLOTB)); glds16(ks_n+(long)(2*KVBLK)*RDM_n,(unsigned)__builtin_amdgcn_readfirstlane(kdst+2*SLOTB));
    { const bf16*Qn=Q+rowbase_n*DM+(long)(q0_n+wid*QBLK+(ln_>>3))*RDM_n+nh_*D+(((ln_&7)^(ln_>>3))*8);
      _Pragma("unroll") for(int i=0;i<4;++i)glds16(Qn+(long)(8*i)*RDM_n,(unsigned)__builtin_amdgcn_readfirstlane(lds0+qst_off+i*1024)); } }
  #undef PKW
  #undef PAF
  #undef VFR
  #undef PIN
  #undef MX3
  #undef GAPA
  #undef GAPB
  #undef EX
  #undef VRD
  #undef KRD
  #undef STEP
  #undef ENDW
  {auto rr=__builtin_amdgcn_permlane32_swap(__float_as_uint(l_reg),__float_as_uint(l_reg),false,false);l_reg=__uint_as_float(rr[0])+__uint_as_float(rr[1]);}
  if(hi==0)wsf[32+r32]=l_reg;asm volatile("s_waitcnt lgkmcnt(0)":::"memory");
  float rli[16];
  #pragma unroll
  for(int r=0;r<16;++r)rli[r]=(MODE==3)?1.0f:__builtin_amdgcn_rcpf(wsf[32+crow(r,hi)]);
  if(MODE==3){ int r32e_=r32; asm volatile("":"+v"(r32e_)); if(hi==0){ const size_t qi_=((size_t)(rowbase+(long)(q0+wid*QBLK+r32e_)*RS))*16+h;     const unsigned long long ml2_=(unsigned long long)__float_as_uint(mhat)|((unsigned long long)__float_as_uint(l_reg)<<32); asm volatile("global_store_dwordx2 %0, %1, off sc0 sc1\n\ts_nop 1"::"v"(ML+qi_*2),"v"(ml2_):"memory"); } }
  bf16*Ow=O+rowbase*DM+(long)(q0+wid*QBLK)*RDM+h*D;
  { bf16*stg=(bf16*)(shm+LDS_OST)+wid*2048;
    #pragma unroll
    for(int r=0;r<16;++r){const int orow=crow(r,hi);
      #pragma unroll
      for(int d0=0;d0<2;++d0)stg[orow*64+d0*32+r32]=__float2bfloat16(o[d0][r]*rli[r]);}
    asm volatile("s_waitcnt lgkmcnt(0)":::"memory");
    #pragma unroll
    for(int i=0;i<4;++i){const int row=i*8+(lane>>3),ch=lane&7; const u32x4 v=*(const u32x4*)(stg+row*64+ch*8); ATTN_STORE16(Ow+(long)row*RDM+ch*8,v);} }
  if(nb_<0){ asm volatile("s_waitcnt lgkmcnt(0)\n\ts_barrier":::"memory"); }
  #undef DMA_K
  #undef DMA_M
  #undef HOOK_TAB
  #undef HOOK_SEL
  #undef WAITB
  #undef DMA_V
  #undef CMASK
  #undef START
  #undef RESC
  #undef ROT
}
constexpr int ATTN_LDS_BYTES=LDS_BYTES;
#undef SBAR
#undef WAIT_BAR
}

__device__ __forceinline__ void hist_pick(const LAS unsigned* hist, int kk, int lane, int& bsel_out, int& krem_out) {
    typedef unsigned u32x4_t __attribute__((ext_vector_type(4)));
    const u32x4_t q = *((const LAS u32x4_t*)hist + lane); const unsigned c0 = q.x, c1 = q.y, c2 = q.z, c3 = q.w;
    const int ls = (int)(c0 + c1 + c2 + c3);
    int suf = ls;
#pragma unroll
    for (int o = 1; o < 64; o <<= 1) { const int v = __builtin_amdgcn_ds_bpermute((lane + o) << 2, suf); if (lane + o < 64) suf += v; }
    const int above = suf - ls;
    const bool mine = (above < kk) && (suf >= kk);
    const unsigned long long bal = __ballot(mine); const int src = __ffsll((long long)bal) - 1;
    int bsel = 0, krem = kk;
    { int acc = above; if (acc + (int)c3 >= kk) { bsel = 3; krem = kk - acc; } else { acc += (int)c3; if (acc + (int)c2 >= kk) { bsel = 2; krem = kk - acc; } else { acc += (int)c2;
          if (acc + (int)c1 >= kk) { bsel = 1; krem = kk - acc; } else { acc += (int)c1; bsel = 0; krem = kk - acc; } } } }
    bsel_out = __builtin_amdgcn_readlane(bsel + 4 * lane, src); krem_out = __builtin_amdgcn_readlane(krem, src);
}
__device__ __forceinline__ void select_row16(const LAS unsigned short* sc, const LAS unsigned* hist0, LAS unsigned* hist1, int t, int row, unsigned long long* MASK, int lane) {
    typedef unsigned u32x4_t __attribute__((ext_vector_type(4)));
    unsigned traw = 0xFC00u;
    if (t + 1 > 256) {
        int b0, k1; hist_pick(hist0, 256, lane, b0, k1);
        const bool pos = b0 >= 128; const unsigned rawhi = pos ? (unsigned)(b0 & 127) : (unsigned)(~b0 & 255);
        hist1[lane] = 0u; hist1[64 + lane] = 0u; hist1[128 + lane] = 0u; hist1[192 + lane] = 0u;
        LDS_WAIT(); asm volatile("" ::: "memory");
        const int ng = (t >> 9) + 1;
        const LAS u32x4_t* sc8 = (const LAS u32x4_t*)sc + lane;
#pragma unroll 2
        for (int g = 0; g < ng; ++g) { const u32x4_t v = sc8[64 * g]; const int s0 = 512 * g + 8 * lane;
#define SEL_P1(word, sh, sx) do { const unsigned x_ = ((word) >> (sh)) & 0xFFFFu; if ((x_ >> 8) == rawhi && (sx) <= t) \
            __hip_atomic_fetch_add(hist1 + (pos ? (x_ & 255u) : (~x_ & 255u)), 1u, __ATOMIC_RELAXED, __HIP_MEMORY_SCOPE_WORKGROUP); } while (0)
            SEL_P1(v.x, 0, s0); SEL_P1(v.x, 16, s0 + 1); SEL_P1(v.y, 0, s0 + 2); SEL_P1(v.y, 16, s0 + 3); SEL_P1(v.z, 0, s0 + 4); SEL_P1(v.z, 16, s0 + 5); SEL_P1(v.w, 0, s0 + 6); SEL_P1(v.w, 16, s0 + 7);
#undef SEL_P1
        }
        LDS_WAIT(); asm volatile("" ::: "memory");
        int b1, k2; hist_pick(hist1, k1, lane, b1, k2);
        traw = pos ? (((unsigned)(b0 & 127) << 8) | (unsigned)b1) : ((~(((unsigned)b0 << 8) | (unsigned)b1)) & 0xFFFFu);
    }
    const _Float16 T = __builtin_bit_cast(_Float16, (unsigned short)traw);
    const int nj = (t >> 6) + 1;
    unsigned long long myword = 0ull;
#pragma unroll 4
    for (int jj = 0; jj < nj; ++jj) { const int s = jj * 64 + lane; const _Float16 x = __builtin_bit_cast(_Float16, sc[s]);
        const unsigned long long word = __ballot(s <= t && x >= T);
        if (lane == jj) myword = word; }
    *(GAS unsigned long long*)(MASK + (size_t)row * 64 + lane) = myword;
}
__device__ __forceinline__ float relu1(float x) { const int i = __builtin_bit_cast(int, x); return __builtin_bit_cast(float, i > 0 ? i : 0); }
#define IDX_WAITBAR(N) asm volatile("s_waitcnt vmcnt(" #N ") lgkmcnt(0)\n\ts_barrier" ::: "memory")
constexpr int IDX_RING_OFF = 65536, IDX_SLOT = 16384;
typedef short idx_bf16x8_t __attribute__((ext_vector_type(8)));
struct IdxPre { idx_bf16x8_t aq[4][4]; idx_bf16x8_t P0[4], P1[4]; f32x4 w; };
__device__ __forceinline__ void idx_prefetch(const Frame& F, int b, int t0, IdxPre& R) {
    const int lane = F.lane, wid = F.wave, n32 = lane & 31, hi = lane >> 5;
    const bf16* QI = (const bf16*)(F.ws + WS_QI); const bf16* KIB = (const bf16*)(F.ws + WS_KIB); const float* WI = (const float*)(F.ws + WS_WI);
    const size_t rowb = (size_t)b * SEQ;
#pragma unroll
    for (int m = 0; m < 4; ++m) { const bf16* qrow = QI + (rowb + t0 + 2 * m + ((n32 >> 2) & 1)) * D + ((n32 & 3) + 4 * (n32 >> 3)) * HD + 8 * hi;
#pragma unroll
        for (int ks = 0; ks < 4; ++ks) R.aq[m][ks] = *(const GAS idx_bf16x8_t*)(qrow + 16 * ks); }
    R.w = (f32x4){0.f, 0.f, 0.f, 0.f};
    if (F.tid < 32) R.w = *(const GAS f32x4*)(WI + (rowb + t0) * 16 + 4 * F.tid);
    const int nb = (t0 + 8 + 31) >> 5, nj = (nb - wid + 7) >> 3;
    const bf16* kp = KIB + rowb * 64 + wid * 2048 + hi * 256 + n32 * 8;
#pragma unroll
    for (int ks = 0; ks < 4; ++ks) { R.P0[ks] = (idx_bf16x8_t){}; R.P1[ks] = (idx_bf16x8_t){}; }
    if (nj > 0) {
#pragma unroll
        for (int ks = 0; ks < 4; ++ks) R.P0[ks] = *(const GAS idx_bf16x8_t*)(kp + 512 * ks); }
    if (nj > 1) {
#pragma unroll
        for (int ks = 0; ks < 4; ++ks) R.P1[ks] = *(const GAS idx_bf16x8_t*)(kp + (size_t)(256 * 64) + 512 * ks); }
}
__device__ __forceinline__ void indexer_unit8(Frame& F, int b, int t0, int nb_, int nt0, IdxPre& R, const int probe_skip = 0) {
    typedef idx_bf16x8_t bf16x8_t; typedef float f32x16_t __attribute__((ext_vector_type(16)));
    const int lane = F.lane, wid = F.wave, n32 = lane & 31, hi = lane >> 5;
    const bf16* KIB = (const bf16*)(F.ws + WS_KIB);
    unsigned long long* MASK = (unsigned long long*)(F.ws + WS_MASK);
    LAS unsigned short* scores = (LAS unsigned short*)(F.lds + RING_OFF);
    const size_t rowb = (size_t)b * SEQ;
    LAS f32x4* wl = (LAS f32x4*)(F.lds + RING_OFF + IDX_RING_OFF + 8192);
    if (F.tid < 32) wl[F.tid] = R.w;
    const int tokh = t0 + hi;
    const int nb = (probe_skip & 16) ? 1 : ((t0 + 8 + 31) >> 5);
    LAS unsigned* hist0 = (LAS unsigned*)(F.lds + AUX_OFF);
    LAS unsigned* myhist = hist0 + hi * 256;
#pragma unroll
    for (int i = 0; i < 4; ++i) hist0[i * 512 + wid * 64 + lane] = 0u;
    asm volatile("s_waitcnt lgkmcnt(0)\n\ts_barrier" ::: "memory");
    const bf16* kp = KIB + (rowb + 32 * wid + n32) * 64 + 8 * hi;
    LAS unsigned short* myrow = scores + hi * 4096 + 32 * wid + n32;
#define IDX_LOADB(dst, blk) do { const bf16* p_ = kp + (size_t)(blk) * (256 * 64); _Pragma("unroll") for (int ks = 0; ks < 4; ++ks) dst[ks] = *(const GAS bf16x8_t*)(p_ + 16 * ks); } while (0)
#define IDX_BLOCK(bf, blk) do { \
        f32x16_t c[4] = {}; \
        _Pragma("unroll") for (int ks = 0; ks < 4; ++ks) _Pragma("unroll") for (int m = 0; m < 4; ++m) c[m] = __builtin_amdgcn_mfma_f32_32x32x16_bf16(R.aq[m][ks], bf[ks], c[m], 0, 0, 0); \
        const int kpos = (wid + 8 * (blk)) * 32 + n32; \
        _Pragma("unroll") for (int m = 0; m < 4; ++m) { \
            const LAS f32x4* wp_ = wl + (2 * m + hi) * 4; const f32x4 wv_[4] = {wp_[0], wp_[1], wp_[2], wp_[3]}; \
            float sa = 0.f, sb = 0.f; \
            _Pragma("unroll") for (int r = 0; r < 16; r += 2) { sa += relu1(c[m][r]) * wv_[r >> 2][r & 3]; sb += relu1(c[m][r + 1]) * wv_[(r + 1) >> 2][(r + 1) & 3]; } \
            const bool ok = kpos <= tokh + 2 * m; \
            const _Float16 hv = (_Float16)(ok ? (sa + sb) : -INFINITY); \
            const unsigned hb = __builtin_bit_cast(unsigned short, hv); \
            myrow[m * 8192 + (blk) * 256] = (unsigned short)hb; \
            if (ok) __hip_atomic_fetch_add(myhist + m * 512 + ((hb & 0x8000u) ? ((~hb >> 8) & 255u) : ((hb >> 8) | 128u)), 1u, __ATOMIC_RELAXED, __HIP_MEMORY_SCOPE_WORKGROUP); \
        } } while (0)
    const int nj = (nb - wid + 7) >> 3;
    bf16x8_t P0[4], P1[4];
#pragma unroll
    for (int ks = 0; ks < 4; ++ks) { P0[ks] = R.P0[ks]; P1[ks] = R.P1[ks]; }
#pragma unroll 1
    for (int jb = 0; jb < nj; jb += 2) {
        bf16x8_t T0[4], T1[4];
        if (jb + 2 < nj) IDX_LOADB(T0, jb + 2);
        IDX_BLOCK(P0, jb);
        if (jb + 1 < nj) {
            if (jb + 3 < nj) IDX_LOADB(T1, jb + 3);
            IDX_BLOCK(P1, jb + 1);
        }
#pragma unroll
        for (int ks = 0; ks < 4; ++ks) { P0[ks] = T0[ks]; P1[ks] = T1[ks]; }
    }
#undef IDX_LOADB
#undef IDX_BLOCK
    IdxPre RN;
    idx_prefetch(F, nt0 >= 0 ? nb_ : b, nt0 >= 0 ? nt0 : t0, RN);
    asm volatile("s_waitcnt lgkmcnt(0)\n\ts_barrier" ::: "memory");
    int lane_s = lane; asm volatile("" : "+v"(lane_s));
    if (!(probe_skip & 1)) select_row16(scores + wid * 4096, hist0 + wid * 256, (LAS unsigned*)(F.lds + RING_OFF + IDX_RING_OFF + wid * 1024), t0 + wid, (int)(rowb + t0 + wid), MASK, lane_s);
    asm volatile("s_waitcnt lgkmcnt(0)\n\ts_barrier" ::: "memory");
#pragma unroll
    for (int m = 0; m < 4; ++m)
#pragma unroll
        for (int ks = 0; ks < 4; ++ks) R.aq[m][ks] = RN.aq[m][ks];
#pragma unroll
    for (int ks = 0; ks < 4; ++ks) { R.P0[ks] = RN.P0[ks]; R.P1[ks] = RN.P1[ks]; }
    R.w = RN.w;
}
__device__ __forceinline__ void indexer_phase16(Frame& F, const int probe_skip = 0) {
    IdxPre R;
    if (F.G == 256) { const int b = F.vcu >> 6, s = F.vcu & 63;
        idx_prefetch(F, b, 8 * s, R);
#pragma unroll 1
        for (int i = 0; i < 8; ++i) { const int oc = (i >> 1) * 128 + ((i & 1) ? 127 - s : s); const int j = i + 1, ocn = (j >> 1) * 128 + ((j & 1) ? 127 - s : s);
            indexer_unit8(F, b, 8 * oc, b, i < 7 ? 8 * ocn : -1, R, probe_skip); }
    } else {
        if (F.vcu < 2048) idx_prefetch(F, F.vcu >> 9, 8 * (F.vcu & 511), R);
#pragma unroll 1
        for (int u = F.vcu; u < 2048; u += F.G) { const int un = u + F.G; indexer_unit8(F, u >> 9, 8 * (u & 511), un >> 9, un < 2048 ? 8 * (un & 511) : -1, R, probe_skip); }
    }
}
constexpr int IDXS_H0 = 0, IDXS_H1 = 16384, IDXS_WL = 24576;
static_assert(IDXS_WL + 1024 <= AUX_BYTES, "indexer LDS");
__device__ __forceinline__ bool idx_unit_at(const Frame& F, int i, int& b, int& t0) {
    if (F.G == 256) { if (i >= 8) return false; const int s = F.vcu & 63; b = F.vcu >> 6; t0 = 8 * ((i >> 1) * 128 + ((i & 1) ? 127 - s : s)); return true; }
    const int u = F.vcu + i * F.G; if (u >= 2048) return false; b = u >> 9; t0 = 8 * (u & 511); return true;
}
#ifndef IDX_ABL_K2
#define IDX_ABL_K2 0
#endif
template <int probe> __device__ __forceinline__ void idx_keys(const Frame& F, int b, int t0, IdxPre& R, LAS unsigned short* scores, LAS unsigned* hist0, const LAS f32x4* wl) {
    typedef idx_bf16x8_t bf16x8_t; typedef float f32x16_t __attribute__((ext_vector_type(16))); typedef _Float16 h2_t __attribute__((ext_vector_type(2)));
    const int lane = F.lane, wid = F.wave, n32 = lane & 31, hi = lane >> 5;
    const bf16* KIB = (const bf16*)(F.ws + WS_KIB);
    const size_t rowb = (size_t)b * SEQ;
    const int tokh = t0 + hi;
    const int nb = (t0 + 8 + 31) >> 5;
    LAS unsigned* myhist = hist0 + hi * 256;
    const bf16* kp = KIB + rowb * 64 + wid * 2048 + hi * 256 + n32 * 8;
    LAS unsigned short* myrow = scores + hi * 4096 + 32 * wid + n32;
    const int nj = (nb - wid + 7) >> 3, njm = nj > 0 ? nj - 1 : 0;
    h2_t wv[4][8];
#pragma unroll
    for (int m = 0; m < 4; ++m)
#pragma unroll
        for (int jq = 0; jq < 4; ++jq) { const f32x4 t = wl[(2 * m + hi) * 4 + jq]; wv[m][2 * jq] = (h2_t){(_Float16)t.x, (_Float16)t.y}; wv[m][2 * jq + 1] = (h2_t){(_Float16)t.z, (_Float16)t.w}; }
#define IDX_LOADB(dst, blk) do { const int bc_ = (blk) < njm ? (blk) : njm; const bf16* p_ = kp + (size_t)bc_ * (256 * 64); _Pragma("unroll") for (int ks = 0; ks < 4; ++ks) dst[ks] = *(const GAS bf16x8_t*)(p_ + 512 * ks); } while (0)
#define IDX_MMA(cd, bf, h) do { cd[0] = (f32x16_t){}; cd[1] = (f32x16_t){}; \
        _Pragma("unroll") for (int ks = 0; ks < 4; ++ks) _Pragma("unroll") for (int mm = 0; mm < 2; ++mm) cd[mm] = __builtin_amdgcn_mfma_f32_32x32x16_bf16(R.aq[2 * (h) + mm][ks], bf[ks], cd[mm], 0, 0, 0); } while (0)
#define IDX_EPI(cs, blk, h) do { const int kpos = (wid + 8 * (blk)) * 32 + n32; \
        _Pragma("unroll") for (int mm = 0; mm < 2; ++mm) { const int m = 2 * (h) + mm; \
            float sa = 0.f, sb = 0.f; \
            _Pragma("unroll") for (int r = 0; r < 16; r += 4) { \
                const h2_t p0_ = __builtin_elementwise_max(__builtin_bit_cast(h2_t, __builtin_amdgcn_cvt_pkrtz(cs[mm][r], cs[mm][r + 1])), (h2_t){(_Float16)0, (_Float16)0}); \
                const h2_t p1_ = __builtin_elementwise_max(__builtin_bit_cast(h2_t, __builtin_amdgcn_cvt_pkrtz(cs[mm][r + 2], cs[mm][r + 3])), (h2_t){(_Float16)0, (_Float16)0}); \
                sa = __builtin_amdgcn_fdot2(p0_, wv[m][r >> 1], sa, false); sb = __builtin_amdgcn_fdot2(p1_, wv[m][(r >> 1) + 1], sb, false); } \
            const bool ok = kpos <= tokh + 2 * m; \
            const _Float16 hv = (_Float16)(ok ? (sa + sb) : -INFINITY); \
            const unsigned hb = __builtin_bit_cast(unsigned short, hv); \
            myrow[m * 8192 + (blk) * 256] = (unsigned short)hb; \
            const unsigned key_ = hb ^ ((unsigned)__builtin_amdgcn_sbfe((int)hb, 15, 1) | 0x8000u);        \
            if (!(probe & 1)) __hip_atomic_fetch_add(myhist + m * 512 + __builtin_amdgcn_ubfe(key_, 8, 8), 1u, __ATOMIC_RELAXED, __HIP_MEMORY_SCOPE_WORKGROUP); \
        } } while (0)
#define IDX_ILV() do { _Pragma("unroll") for (int g_ = 0; g_ < 8; ++g_) { __builtin_amdgcn_sched_group_barrier(0x008, 1, 0); __builtin_amdgcn_sched_group_barrier(0x002, 9, 0); } } while (0)
    bf16x8_t P0[4], T0[4];
#pragma unroll
    for (int ks = 0; ks < 4; ++ks) { P0[ks] = R.P0[ks]; T0[ks] = R.P1[ks]; }
    __builtin_amdgcn_s_waitcnt(0x0070);
    if (nj > 0) {
        f32x16_t cA[2], cB[2];
        IDX_MMA(cA, P0, 0);
        const int npair = nj >> 1;
#pragma unroll 1
        for (int jb = 0; jb < 2 * npair; jb += 2) {
            IDX_MMA(cB, P0, 1); IDX_EPI(cA, jb, 0); IDX_ILV();
            IDX_LOADB(P0, jb + 2);
            IDX_MMA(cA, T0, 0); IDX_EPI(cB, jb, 1); IDX_ILV();
            IDX_MMA(cB, T0, 1); IDX_EPI(cA, jb + 1, 0); IDX_ILV();
            IDX_LOADB(T0, jb + 3);
            IDX_MMA(cA, P0, 0); IDX_EPI(cB, jb + 1, 1); IDX_ILV();
        }
        if (nj & 1) { const int jb = 2 * npair; IDX_MMA(cB, P0, 1); IDX_EPI(cA, jb, 0); IDX_EPI(cB, jb, 1); }
    }
#undef IDX_LOADB
#undef IDX_MMA
#undef IDX_EPI
#undef IDX_ILV
}
template <int probe> __device__ __forceinline__ void indexer_phase_stag(Frame& F) {
    const int wid = F.wave;
    const bool grpB = wid >= 4;
    LAS unsigned short* sc = (LAS unsigned short*)(F.lds + RING_OFF);
    LAS unsigned* h0 = (LAS unsigned*)(F.lds + AUX_OFF + IDXS_H0);
    LAS unsigned* h1 = (LAS unsigned*)(F.lds + AUX_OFF + IDXS_H1) + wid * 256;
    LAS f32x4* wl = (LAS f32x4*)(F.lds + AUX_OFF + IDXS_WL);
    unsigned long long* MASK = (unsigned long long*)(F.ws + WS_MASK);
    int cb = 0, ct0 = 0;
    if (!idx_unit_at(F, 0, cb, ct0)) return;
    IdxPre R; idx_prefetch(F, cb, ct0, R);
#pragma unroll
    for (int i = 0; i < 8; ++i) h0[i * 512 + F.tid] = 0u;
    if (F.tid < 32) wl[F.tid] = R.w;
    asm volatile("s_waitcnt lgkmcnt(0)\n\ts_barrier" ::: "memory");
    bool hasK = true, hasS = false; int pb = 0, pt0 = 0;
#pragma unroll 1
    for (int s = 0; hasK || hasS; ++s) {
        const int p = s & 1;
        int nb_ = cb, nt0 = ct0; bool hasN = false;
        if (!hasK && p == 0 && F.G == 256)
            attn_body::preissue_kv0((const attn_body::bf16*)(F.ws + WS_K), (const attn_body::bf16*)(F.ws + WS_V), F.vcu >> 6, (F.vcu >> 3) & 7, (char*)F.lds + RING_OFF, wid);
#pragma unroll 1
        for (int half = 0; half < 2; ++half) {
            if ((half == 0) == grpB) {
                if (hasS && !(probe & 2)) { int lane_s = F.lane; asm volatile("" : "+v"(lane_s));
                    select_row16(sc + (p ^ 1) * 32768 + wid * 4096, h0 + (p ^ 1) * 2048 + wid * 256, h1, pt0 + wid, pb * SEQ + pt0 + wid, MASK, lane_s); }
            } else if (hasK) {
                idx_keys<probe>(F, cb, ct0, R, sc + p * 32768, h0 + p * 2048, wl + p * 32);
                if (IDX_ABL_K2) idx_keys<1>(F, cb, ct0, R, sc + p * 32768, h0 + p * 2048, wl + p * 32);
                hasN = idx_unit_at(F, s + 1, nb_, nt0);
                idx_prefetch(F, nb_, nt0, R);
            }
        }
        { LAS unsigned* hz = h0 + (p ^ 1) * 2048 + wid * 256 + F.lane;
            hz[0] = 0u; hz[64] = 0u; hz[128] = 0u; hz[192] = 0u; }
        if (hasN && F.tid < 32) wl[(p ^ 1) * 32 + F.tid] = R.w;
        asm volatile("s_waitcnt lgkmcnt(0)\n\ts_barrier" ::: "memory");
        pb = cb; pt0 = ct0; hasS = hasK; cb = nb_; ct0 = nt0; hasK = hasN;
    }
}

template <int MODE> __device__ __forceinline__ void attn_phase(Frame& F, const Args& A, attn_body::QP& qp, bool dry = false) {
    using attn_body::bf16;
    bf16* Q = (bf16*)(F.ws + WS_Q); bf16* O = dry ? (bf16*)(F.ws + WS_END) : Q; const bf16* K = (const bf16*)(F.ws + WS_K); const bf16* V = (const bf16*)(F.ws + WS_V);
    const float* rb = A.in[5]; const float* KM = (const float*)(F.ws + WS_KM); const unsigned* MASK32 = (const unsigned*)(F.ws + WS_MASK);
    char* shm = (char*)F.lds + RING_OFF;
    static_assert(attn_body::ATTN_LDS_BYTES <= RING_BYTES, "attention scratch fits the ring region");
    if (MODE == 3) {
        bf16* OFp = (bf16*)(F.ws + WS_QI); float* MLp = (float*)(F.ws + WS_MASK);
        if (F.G == 256) { const int bh = F.vcu >> 2, s = F.vcu & 3;
#pragma unroll 1
            for (int i = 0; i < 4; ++i) attn_body::attn_unit<3, 8>(bh >> 4, bh & 15, s + 4 * i, Q, K, V, OFp, shm, F.wave, rb, KM, MASK32, i == 0, qp, OFp, MLp, bh >> 4, bh & 15, i < 3 ? s + 4 * (i + 1) : s, i > 0, i == 3, i > 0);
        } else {
#pragma unroll 1
            for (int u = F.vcu; u < 1024; u += F.G) attn_body::attn_unit<3, 8>(u >> 8, (u >> 4) & 15, u & 15, Q, K, V, OFp, shm, F.wave, rb, KM, MASK32, true, qp, OFp, MLp);
        }
    } else if (MODE == 4) {
        const bf16* OFp = (const bf16*)(F.ws + WS_QI); float* MLp = (float*)(F.ws + WS_MASK);
        if (F.G == 256) { const int bh = F.vcu >> 2, s = F.vcu & 3;
#pragma unroll 1
            for (int i = 0; i < 4; ++i) { const int qb = i == 0 ? s : (i == 1 ? 7 - s : (i == 2 ? 8 + s : 15 - s)); const int qn = i == 0 ? 7 - s : (i == 1 ? 8 + s : 15 - s); attn_body::attn_unit<4, 8>(bh >> 4, bh & 15, qb, Q, K, V, O, shm, F.wave, rb, KM, MASK32, i == 0, qp, OFp, MLp, i < 3 ? (bh >> 4) : -1, bh & 15, qn, 1, false, true); }
        } else {
#pragma unroll 1
            for (int u = F.vcu; u < 1024; u += F.G) attn_body::attn_unit<4, 8>(u >> 8, (u >> 4) & 15, u & 15, Q, K, V, O, shm, F.wave, rb, KM, MASK32, true, qp, OFp, MLp);
        }
    } else if (MODE == 2) {
        if (F.G == 256) { const int bh = F.vcu >> 2, s = F.vcu & 3;
#pragma unroll 1
            for (int i = 0; i < 4; ++i) { const int qb = i == 0 ? s : (i == 1 ? 7 - s : (i == 2 ? 8 + s : 15 - s)); attn_body::attn_unit<MODE, 8>(bh >> 4, bh & 15, qb, Q, K, V, O, shm, F.wave, rb, KM, MASK32, i == 0, qp); }
        } else {
#pragma unroll 1
            for (int u = F.vcu; u < 1024; u += F.G) attn_body::attn_unit<MODE, 8>(u >> 8, (u >> 4) & 15, u & 15, Q, K, V, O, shm, F.wave, rb, KM, MASK32, true, qp);
        }
    } else {
        const int hoff = MODE == 1 ? 8 : 0;
        if (F.G == 256) { const int bh = F.vcu >> 3, s = F.vcu & 7;
#pragma unroll 1
            for (int i = 0; i < 2; ++i) { const int qb = i == 0 ? s : 15 - s; const bool nx = MODE == 0 && i == 1;
                attn_body::attn_unit<MODE, 8>(bh >> 3, hoff + (bh & 7), qb, Q, K, V, O, shm, F.wave, rb, KM, MASK32, i == 0, qp, nullptr, nullptr, (i == 0 || nx) ? (bh >> 3) : -1, (nx ? 8 : hoff) + (bh & 7), nx ? s : 15 - s, (MODE == 1 && i == 0) ? 2 : 1, nx, MODE == 1 || i > 0); }
        } else {
#pragma unroll 1
            for (int u = F.vcu; u < 512; u += F.G) attn_body::attn_unit<MODE, 8>(u >> 7, hoff + ((u >> 4) & 7), u & 15, Q, K, V, O, shm, F.wave, rb, KM, MASK32, true, qp);
        }
    }
}

__global__ void __launch_bounds__(NWAVES * 64, 2) mk_fwd(Args args) {
    extern __shared__ __attribute__((aligned(16))) unsigned char lds[];
    Frame F;
    F.lds = (LAS unsigned char*)lds;
    F.MISC = (volatile LAS unsigned*)(F.lds + MISC_OFF);
    F.wave = __builtin_amdgcn_readfirstlane(threadIdx.x >> 6); F.lane = hw_lane(); F.tid = F.wave * 64 + F.lane;
    F.G = gridDim.x; { const int bx = blockIdx.x; F.vcu = (F.G % 8 == 0) ? (bx % 8) * (F.G / 8) + bx / 8 : bx; }
    F.out = args.out; F.ws = args.ws;
    for (int u = F.tid; u < (LDS_BYTES - LDSCTL_OFF) / 4; u += NWAVES * 64) ((LAS unsigned*)(F.lds + LDSCTL_OFF))[u] = 0u;
    __syncthreads();
    XcdBarrier bar = xcd_barrier_post((unsigned*)(F.ws + WS_BAR), F.MISC + 8, F.wave);
#define GRID_BAR() do { REP(8) xcd_barrier(bar); } while (0)
#define SEAM_BAR() do { if (F.G == 256) group_barrier(bar, 32u); else xcd_barrier(bar); } while (0)
#define FILL_RSTD(SSIN) \
            { pg8::Unit u_; PG8_LAS float* rt_ = (PG8_LAS float*)(F.lds + AUX_OFF + 2048);       \
              for (int i_ = 0; i_ < 6 && S.next(i_, u_); ++i_) if (F.tid < 256) rt_[i_ * 256 + F.tid] = pg8::row_rstd(SSIN, u_.pm * 256 + F.tid); __syncthreads(); }
#define PHASE_PTRS() RELAUNDER(F); unsigned char* ws = F.ws; \
    pg8::bf16_t* XB = (pg8::bf16_t*)(ws + WS_XB); pg8::bf16_t* Qb = (pg8::bf16_t*)(ws + WS_Q); pg8::bf16_t* Kb = (pg8::bf16_t*)(ws + WS_K); pg8::bf16_t* Vb = (pg8::bf16_t*)(ws + WS_V); \
    pg8::bf16_t* QIb = (pg8::bf16_t*)(ws + WS_QI); pg8::bf16_t* KIBb = (pg8::bf16_t*)(ws + WS_KIB); pg8::bf16_t* Gb = (pg8::bf16_t*)(ws + WS_G); float* SS = (float*)(ws + WS_SS); \
    (void)XB; (void)Qb; (void)Kb; (void)Vb; (void)QIb; (void)KIBb; (void)Gb; (void)SS

    p0_prologue(F, args); GRID_BAR();

#pragma unroll 1
    for (int L = 0; L < DEPTH; ++L) {
        const bool even = !(L & 1); const int j = L >> 1;
        {
            PHASE_PTRS();
            const int N = even ? NIN_E : NIN_O;
            pg8::Gemm g{XB, (const pg8::bf16_t*)(ws + WS_WIN), M, N, D}; pg8::StaticOrder S; S.init(M, N, F.G, (int)blockIdx.x);
            pg8::EpiIn E{Qb, Kb, Vb, QIb, KIBb, (float*)(ws + WS_WI), (float*)(ws + WS_KM), (const PG8_LAS float*)(F.lds + AUX_OFF + 2048), even ? 1 : 0, (PG8_LAS float*)(F.lds + AUX_OFF), SS + (size_t)M * 4};
#if (PROBE_DUP & 64)
            { pg8::EpiInT<true> E2{E.Q, E.K, E.V, E.QI, E.KIB, E.WI, E.KM, E.rtab, E.even, E.ex, E.ssin}; pg8::gemm_phase<pg8::EpiInT<true>, pg8::StaticOrder, true, true>(F.lds + RING_OFF, g, S, E2, F.wave); }
#endif
            if (even && F.G == 256) {
                pg8::Gemm g16{XB, (const pg8::bf16_t*)(ws + WS_WIN), M, 4096, D}; pg8::StaticOrder S16; S16.init(M, 4096, F.G, (int)blockIdx.x);
                pg8::gemm_phase<pg8::EpiIn, pg8::StaticOrder, true, true>(F.lds + RING_OFF, g16, S16, E, F.wave);
                pg8::TailHalves T; T.init(16, (int)blockIdx.x);
                pg8::gemm_phase<pg8::EpiIn, pg8::TailHalves, true, true, true>(F.lds + RING_OFF, g, T, E, F.wave);
            } else {
                REP(1) pg8::gemm_phase<pg8::EpiIn, pg8::StaticOrder, true, true>(F.lds + RING_OFF, g, S, E, F.wave);
            }
        }
        if (L == 0) {
            RELAUNDER(F);
            const int nun = (M / 256) * (NIN_E / 256), full = nun / F.G, rem = F.G == 256 ? 128 : nun - full * F.G;
            if (rem > 0 && rem < F.G) { if ((int)blockIdx.x >= rem) convert_layer(F, args, 0, ((int)blockIdx.x - rem) * NWAVES + F.wave, (F.G - rem) * NWAVES, 14); }
            else convert_layer(F, args, 0, F.vcu * NWAVES + F.wave, F.G * NWAVES, 14);
        }
        GRID_BAR();
        RELAUNDER(F);
#if defined(MK_SIMPLE_ATTN)
        if (even) { simple_indexer(F, j); RELAUNDER(F); simple_moba(F, args, j); GRID_BAR(); RELAUNDER(F); simple_dsa(F, args); }
        else simple_dilated(F, args);
#else
        attn_body::QP qp; qp.w = 0;
        if (even) { REP(4) { if ((PROBE_DUP & 0x700) && rep_ == 0) indexer_phase_stag<(PROBE_DUP >> 8) & 7>(F); else indexer_phase_stag<0>(F); } xcd_split_arrive(bar); RELAUNDER(F); REP(2 | 256) attn_phase<0>(F, args, qp, (PROBE_DUP & (2 | 256)) && rep_ == 0); xcd_split_wait(bar, (unsigned)(j + 1)); RELAUNDER(F);     REP(2 | 512) attn_phase<1>(F, args, qp, (PROBE_DUP & (2 | 512)) && rep_ == 0); }
        else { attn_phase<3>(F, args, qp); if (F.G == 256) quad_barrier(bar, (unsigned)F.vcu >> 2); else GRID_BAR(); RELAUNDER(F); attn_phase<4>(F, args, qp); }
#endif
        GRID_BAR();
        {
            PHASE_PTRS();
            pg8::Gemm g{Qb, (const pg8::bf16_t*)(ws + ((L & 1) ? WS_WO2 : WS_WO)), M, D, D}; pg8::StaticOrder S; S.init(M, D, F.G, (int)blockIdx.x);
            pg8::EpiRes E{XB, SS, (PG8_LAS float*)(F.lds + AUX_OFF)};
            pg8::gemm_phase<pg8::EpiRes, pg8::StaticOrder, true, true>(F.lds + RING_OFF, g, S, E, F.wave);
        }
        SEAM_BAR();
        {
            PHASE_PTRS();
            pg8::Gemm g{XB, (const pg8::bf16_t*)(ws + ((L & 1) ? WS_WUP2 : WS_WUP)), M, NUP, D}; pg8::StaticOrder S; S.init(M, NUP, F.G, (int)blockIdx.x);
            pg8::EpiUp E{Gb, (float*)(ws + WS_UE), (const PG8_LAS float*)(F.lds + AUX_OFF + 2048), (const float*)(ws + WS_CW) + (size_t)L * 4 * NUP, (const float*)(ws + WS_CW) + (size_t)L * 4 * NUP + 3 * NUP, (PG8_LAS float*)(F.lds + AUX_OFF), SS};
#if (PROBE_DUP & 64)
            { pg8::EpiUpT<true> E2{E.G, E.UE, E.rtab, E.cw, E.cb, E.ex, E.ssin}; pg8::gemm_phase<pg8::EpiUpT<true>, pg8::StaticOrder, true, true>(F.lds + RING_OFF, g, S, E2, F.wave); }
#endif
            REP(1) pg8::gemm_phase<pg8::EpiUp, pg8::StaticOrder, true, true>(F.lds + RING_OFF, g, S, E, F.wave);
        }
        if (L + 1 < DEPTH) {
            RELAUNDER(F);
            const int nun = (M / 256) * (NUP / 256), full = nun / F.G, rem = nun - full * F.G;
            if (rem > 0 && rem < F.G) { if ((int)blockIdx.x >= rem) REP(16) convert_layer(F, args, L + 1, ((int)blockIdx.x - rem) * NWAVES + F.wave, (F.G - rem) * NWAVES); }
            else REP(16) convert_layer(F, args, L + 1, F.vcu * NWAVES + F.wave, F.G * NWAVES);
        }
        GRID_BAR();
        {
            PHASE_PTRS();
            pg8::StaticOrder S; S.init(M, D, F.G, (int)blockIdx.x);
            { pg8::Unit u; for (int i = 0; S.next(i, u); ++i) if (u.pm & 15) fix_rows(F, args, u.pm, L); }
            VM_WAIT(); __syncthreads();
            pg8::Gemm g{Gb, (const pg8::bf16_t*)(ws + WS_WDN) + (size_t)(L & 1) * D * FF, M, D, FF};
            pg8::EpiRes E{XB, SS + (size_t)M * 4, (PG8_LAS float*)(F.lds + AUX_OFF)};
            pg8::gemm_phase<pg8::EpiRes, pg8::StaticOrder, true, true>(F.lds + RING_OFF, g, S, E, F.wave);
        }
        SEAM_BAR();
    }
    RELAUNDER(F);
    final_norm(F, args);
#undef GRID_BAR
#undef FILL_RSTD
#undef PHASE_PTRS
}

extern "C" void kernel_launch(void* const* d_in, const int* in_sizes, int n_in, void* d_out, int out_size, void* d_ws, size_t ws_size, hipStream_t stream) {
    static int grid = 0;
    if (grid == 0) {
        if (n_in != 13 || in_sizes[0] != M * D || out_size != M * D || ws_size < WS_END) { fprintf(stderr, "kernel_launch: unexpected problem (n_in %d, in0 %d, out %d, ws %zu)\n", n_in, n_in > 0 ? in_sizes[0] : -1, out_size, ws_size); grid = -1; return; }
        int dev = 0, cus = 0, per_cu = 0;
        if (hipGetDevice(&dev) != hipSuccess || hipDeviceGetAttribute(&cus, hipDeviceAttributeMultiprocessorCount, dev) != hipSuccess) { grid = -1; return; }
        if (hipFuncSetAttribute((const void*)mk_fwd, hipFuncAttributeMaxDynamicSharedMemorySize, LDS_BYTES) != hipSuccess) { fprintf(stderr, "kernel_launch: hipFuncSetAttribute failed\n"); grid = -1; return; }
        if (hipOccupancyMaxActiveBlocksPerMultiprocessor(&per_cu, (const void*)mk_fwd, NWAVES * 64, LDS_BYTES) != hipSuccess || per_cu < 1) { fprintf(stderr, "kernel_launch: occupancy query says %d blocks per CU\n", per_cu); grid = -1; (void)hipGetLastError(); return; }
        grid = cus;
    }
    if (grid < 0) return;
    if (hipMemsetAsync((char*)d_ws + WS_BAR, 0, BAR_ZERO_BYTES, stream) != hipSuccess) return;
    Args a{};
    for (int i = 0; i < 13; ++i) a.in[i] = (const float*)d_in[i];
    a.out = (float*)d_out; a.ws = (unsigned char*)d_ws;
    hipLaunchKernelGGL(mk_fwd, dim3(grid), dim3(NWAVES * 64), LDS_BYTES, stream, a);
}
```
